# Optimizing an MI355X kernel written in HIP

```python
import math
import jax, jax.numpy as jnp
from jax import lax
import numpy as np

D_MODEL = 2048
BATCH = 4
SEQ = 2048
DEPTH = 4

N_MIXERS = 4
HEAD_DIM = 128
N_HEADS = 16
N_KV_HEADS = 4
GQA_GROUP = N_HEADS // N_KV_HEADS
GQA_IN = (N_HEADS + 2 * N_KV_HEADS) * HEAD_DIM
Q_BLOCK = 128
WINDOW = 128
ROPE_THETA = 500000.0
ROT_DIM = HEAD_DIM // 4
AXIAL_THETA = 10000.0
GRID_W = 64
MLA_Q_RANK = 512
MLA_KV_RANK = 512
MLA_NOPE_DIM = 128
MLA_ROPE_DIM = 64
MLA_V_DIM = 128
MLA_QK_DIM = MLA_NOPE_DIM + MLA_ROPE_DIM
MLA_IN = MLA_Q_RANK + MLA_KV_RANK + MLA_ROPE_DIM
NA_ROWS = 8
NA_COLS = 16
NA_QCOLS = 16
NA_KCOLS = 2 * NA_COLS
MEM_TOKENS = 256
XA_HEADS = 4
XA_HEAD_DIM = 128
N_EXPERTS = 16
EC_CAPACITY = 2
EXPERT_FF = 1024
EPS = 1e-6

kernel_name = "hybrid_interleaved_encoder_ec_moe"


def _n_layers_of(m):
    return len(range(m, DEPTH, N_MIXERS))


def _rms_norm(x, g):
    xf = x.astype(jnp.float32)
    y = xf * lax.rsqrt(jnp.mean(xf * xf, axis=-1, keepdims=True) + EPS)
    return (y * g.astype(jnp.float32)).astype(x.dtype)


def _rope_table(pos, dim, theta):
    inv = jnp.power(jnp.float32(theta), -(jnp.arange(0, dim, 2, dtype=jnp.float32) / dim))
    ang = pos.astype(jnp.float32)[:, None] * inv[None, :]
    return jnp.cos(ang), jnp.sin(ang)


def _rope(x, cos, sin):
    xf = x.astype(jnp.float32)
    half = x.shape[-1] // 2
    c, s = cos[None, :, None, :], sin[None, :, None, :]
    x1, x2 = xf[..., :half], xf[..., half:]
    return jnp.concatenate([x1 * c - x2 * s, x2 * c + x1 * s], axis=-1).astype(x.dtype)


def _partial_rope(x, cos, sin):
    return jnp.concatenate([_rope(x[..., :ROT_DIM], cos, sin), x[..., ROT_DIM:]], axis=-1)


def _split_gqa(xn, w_in):
    B, S, _ = xn.shape
    qkv = xn @ w_in
    nq, nk = N_HEADS * HEAD_DIM, N_KV_HEADS * HEAD_DIM
    q = qkv[..., :nq].reshape(B, S, N_HEADS, HEAD_DIM)
    k = qkv[..., nq:nq + nk].reshape(B, S, N_KV_HEADS, HEAD_DIM)
    v = qkv[..., nq + nk:].reshape(B, S, N_KV_HEADS, HEAD_DIM)
    return q, k, v


def _dense_blocked_attention(q, k, v):
    B, S, KV, G, dk = q.shape
    nb = S // Q_BLOCK
    scale = dk ** -0.5
    qb = q.reshape(B, nb, Q_BLOCK, KV, G, dk).transpose(1, 0, 2, 3, 4, 5)

    def one_block(qi):
        s = jnp.einsum('bqkgd,bskd->bkgqs', qi, k).astype(jnp.float32) * scale
        p = jax.nn.softmax(s, axis=-1).astype(v.dtype)
        return jnp.einsum('bkgqs,bskv->bqkgv', p, v)

    o = lax.map(one_block, qb)
    return o.transpose(1, 0, 2, 3, 4, 5).reshape(B, S, KV * G * v.shape[-1])


def _mixer_window_sink(xn, w_in, sink, w_out):
    B, S, _ = xn.shape
    q, k, v = _split_gqa(xn, w_in)
    cos, sin = _rope_table(jnp.arange(S), ROT_DIM, ROPE_THETA)
    q, k = _partial_rope(q, cos, sin), _partial_rope(k, cos, sin)
    nb = S // Q_BLOCK

    def bands(t):
        tp = jnp.pad(t, ((0, 0), (Q_BLOCK, Q_BLOCK), (0, 0), (0, 0)))
        tp = tp.reshape(B, nb + 2, Q_BLOCK, N_KV_HEADS, HEAD_DIM)
        return jnp.concatenate([tp[:, :-2], tp[:, 1:-1], tp[:, 2:]], axis=2)

    kb, vb = bands(k), bands(v)
    qb = q.reshape(B, nb, Q_BLOCK, N_KV_HEADS, GQA_GROUP, HEAD_DIM)
    s = jnp.einsum('bnqkgd,bnskd->bnkgqs', qb, kb).astype(jnp.float32) * HEAD_DIM ** -0.5
    qpos = jnp.arange(nb)[:, None] * Q_BLOCK + jnp.arange(Q_BLOCK)[None, :]
    kpos = jnp.arange(nb)[:, None] * Q_BLOCK - Q_BLOCK + jnp.arange(3 * Q_BLOCK)[None, :]
    kp = kpos[:, None, :]
    valid = (kp >= 0) & (kp < S) & (jnp.abs(qpos[:, :, None] - kp) <= WINDOW)
    s = jnp.where(valid[None, :, None, None], s, -jnp.inf)
    sk = sink.astype(jnp.float32).reshape(N_KV_HEADS, GQA_GROUP)[None, None, :, :, None, None]
    m = jnp.maximum(jnp.max(s, axis=-1, keepdims=True), sk)
    e = jnp.exp(s - m)
    p = e / (jnp.sum(e, axis=-1, keepdims=True) + jnp.exp(sk - m))
    o = jnp.einsum('bnkgqs,bnskd->bnqkgd', p.astype(vb.dtype), vb)
    return o.reshape(B, S, N_HEADS * HEAD_DIM) @ w_out


def _mixer_axial(xn, w_in, q_norm_g, k_norm_g, w_out):
    B, S, _ = xn.shape
    q, k, v = _split_gqa(xn, w_in)
    q, k = _rms_norm(q, q_norm_g), _rms_norm(k, k_norm_g)
    t = jnp.arange(S)
    half = HEAD_DIM // 2
    cr, sr = _rope_table(t // GRID_W, half, AXIAL_THETA)
    cc, sc = _rope_table(t % GRID_W, half, AXIAL_THETA)

    def axial(u):
        return jnp.concatenate([_rope(u[..., :half], cr, sr), _rope(u[..., half:], cc, sc)], axis=-1)

    q = axial(q).reshape(B, S, N_KV_HEADS, GQA_GROUP, HEAD_DIM)
    o = _dense_blocked_attention(q, axial(k), v)
    return o @ w_out


def _mixer_mla(xn, w_in, q_lat_g, kv_lat_g, w_uq, w_ukv, w_out):
    B, S, _ = xn.shape
    lat = xn @ w_in
    c_q = _rms_norm(lat[..., :MLA_Q_RANK], q_lat_g)
    c_kv = _rms_norm(lat[..., MLA_Q_RANK:MLA_Q_RANK + MLA_KV_RANK], kv_lat_g)
    k_rope = lat[..., MLA_Q_RANK + MLA_KV_RANK:].reshape(B, S, 1, MLA_ROPE_DIM)
    q = (c_q @ w_uq).reshape(B, S, N_HEADS, MLA_QK_DIM)
    kv = (c_kv @ w_ukv).reshape(B, S, N_HEADS, MLA_NOPE_DIM + MLA_V_DIM)
    cos, sin = _rope_table(jnp.arange(S), MLA_ROPE_DIM, ROPE_THETA)
    q = jnp.concatenate([q[..., :MLA_NOPE_DIM], _rope(q[..., MLA_NOPE_DIM:], cos, sin)], axis=-1)
    k_rope = jnp.broadcast_to(_rope(k_rope, cos, sin), (B, S, N_HEADS, MLA_ROPE_DIM))
    k = jnp.concatenate([kv[..., :MLA_NOPE_DIM], k_rope], axis=-1)
    v = kv[..., MLA_NOPE_DIM:]
    o = _dense_blocked_attention(q.reshape(B, S, N_HEADS, 1, MLA_QK_DIM), k, v)
    return o @ w_out


def _mixer_neighbourhood(xn, w_in, rpb, w_out):
    B, S, _ = xn.shape
    q, k, v = _split_gqa(xn, w_in)
    rows = S // GRID_W
    kr = min(NA_ROWS, rows)
    ncb = GRID_W // NA_QCOLS
    r = jnp.arange(rows)
    row_idx = jnp.clip(r - NA_ROWS // 2, 0, rows - kr)[:, None] + jnp.arange(kr)[None, :]
    qcol = jnp.arange(GRID_W).reshape(ncb, NA_QCOLS)
    c_start = jnp.clip(qcol - NA_COLS // 2, 0, GRID_W - NA_COLS)
    kcol = (jnp.clip(jnp.arange(ncb) * NA_QCOLS - NA_COLS // 2, 0, GRID_W - NA_KCOLS)[:, None]
            + jnp.arange(NA_KCOLS)[None, :])

    def gather(t):
        tg = t.reshape(B, rows, GRID_W, N_KV_HEADS, HEAD_DIM)[:, row_idx[:, None, :, None], kcol[None, :, None, :]]
        return tg.reshape(B, rows, ncb, kr * NA_KCOLS, N_KV_HEADS, HEAD_DIM)

    kg, vg = gather(k), gather(v)
    qg = q.reshape(B, rows, ncb, NA_QCOLS, N_KV_HEADS, GQA_GROUP, HEAD_DIM)
    s = jnp.einsum('brcqkgd,brcskd->brckgqs', qg, kg).astype(jnp.float32) * HEAD_DIM ** -0.5
    dr = row_idx - r[:, None] + NA_ROWS - 1
    dc = jnp.clip(kcol[:, None, :] - qcol[:, :, None] + NA_COLS - 1, 0, 2 * NA_COLS - 2)
    bias = rpb.astype(jnp.float32)[:, dr[:, None, None, :, None], dc[None, :, :, None, :]]
    bias = bias.reshape(N_KV_HEADS, GQA_GROUP, rows, ncb, NA_QCOLS, kr * NA_KCOLS).transpose(2, 3, 0, 1, 4, 5)
    in_win = (kcol[:, None, :] >= c_start[:, :, None]) & (kcol[:, None, :] < c_start[:, :, None] + NA_COLS)
    in_win = jnp.broadcast_to(in_win[:, :, None, :], (ncb, NA_QCOLS, kr, NA_KCOLS)).reshape(ncb, NA_QCOLS, kr * NA_KCOLS)
    s = jnp.where(in_win[None, None, :, None, None], s + bias[None], -jnp.inf)
    p = jax.nn.softmax(s, axis=-1).astype(vg.dtype)
    o = jnp.einsum('brckgqs,brcskd->brcqkgd', p, vg)
    return o.reshape(B, S, N_HEADS * HEAD_DIM) @ w_out


def _memory_cross_attention(xn, mem_n, wq, wkv, wo):
    B, S, _ = xn.shape
    M = mem_n.shape[1]
    inner = XA_HEADS * XA_HEAD_DIM
    q = (xn @ wq).reshape(B, S, XA_HEADS, XA_HEAD_DIM)
    kv = mem_n @ wkv
    k = kv[..., :inner].reshape(B, M, XA_HEADS, XA_HEAD_DIM)
    v = kv[..., inner:].reshape(B, M, XA_HEADS, XA_HEAD_DIM)
    s = jnp.einsum('bshd,bmhd->bhsm', q, k).astype(jnp.float32) * XA_HEAD_DIM ** -0.5
    p = jax.nn.softmax(s, axis=-1).astype(v.dtype)
    o = jnp.einsum('bhsm,bmhd->bshd', p, v).reshape(B, S, inner)
    return o @ wo


def _expert_choice_ffn(xn, router_w, w_gate, w_up, w_down):
    B, S, _ = xn.shape
    cap = EC_CAPACITY * S // N_EXPERTS
    aff = jax.nn.softmax((xn @ router_w).astype(jnp.float32), axis=-1)
    gate, idx = lax.top_k(aff.transpose(0, 2, 1), cap)
    bidx = jnp.arange(B)[:, None, None]
    xg = xn[bidx, idx]
    h = jax.nn.silu(jnp.einsum('becd,edf->becf', xg, w_gate)) * jnp.einsum('becd,edf->becf', xg, w_up)
    y = jnp.einsum('becf,efd->becd', h, w_down) * gate[..., None].astype(xn.dtype)
    return jnp.zeros_like(xn).at[bidx, idx].add(y)


def setup_inputs(seed: int = 0) -> dict:
    key = jax.random.key(seed)
    ks = iter(jax.random.split(key, 40))

    def dense(shape, fan_in):
        return jax.random.normal(next(ks), shape, jnp.float32) * fan_in ** -0.5

    def gain(shape):
        return 1.0 + 0.05 * jax.random.normal(next(ks), shape, jnp.float32)

    nA, nB, nC, nD = (_n_layers_of(m) for m in range(N_MIXERS))
    D = D_MODEL
    return {
        'x': jax.random.normal(next(ks), (BATCH, SEQ, D), jnp.float32),
        'mem': jax.random.normal(next(ks), (BATCH, MEM_TOKENS, D), jnp.float32),
        'norm_mix_g': gain((DEPTH, D)),
        'norm_xa_g': gain((DEPTH, D)),
        'norm_ffn_g': gain((DEPTH, D)),
        'a_w_in': dense((nA, D, GQA_IN), D),
        'a_sink': 0.5 * jax.random.normal(next(ks), (nA, N_HEADS), jnp.float32),
        'a_w_out': dense((nA, N_HEADS * HEAD_DIM, D), N_HEADS * HEAD_DIM),
        'b_w_in': dense((nB, D, GQA_IN), D),
        'b_q_norm_g': gain((nB, HEAD_DIM)),
        'b_k_norm_g': gain((nB, HEAD_DIM)),
        'b_w_out': dense((nB, N_HEADS * HEAD_DIM, D), N_HEADS * HEAD_DIM),
        'c_w_in': dense((nC, D, MLA_IN), D),
        'c_q_lat_norm_g': gain((nC, MLA_Q_RANK)),
        'c_kv_lat_norm_g': gain((nC, MLA_KV_RANK)),
        'c_w_uq': dense((nC, MLA_Q_RANK, N_HEADS * MLA_QK_DIM), MLA_Q_RANK),
        'c_w_ukv': dense((nC, MLA_KV_RANK, N_HEADS * (MLA_NOPE_DIM + MLA_V_DIM)), MLA_KV_RANK),
        'c_w_out': dense((nC, N_HEADS * MLA_V_DIM, D), N_HEADS * MLA_V_DIM),
        'd_w_in': dense((nD, D, GQA_IN), D),
        'd_rpb': 0.1 * jax.random.normal(next(ks), (nD, N_HEADS, 2 * NA_ROWS - 1, 2 * NA_COLS - 1), jnp.float32),
        'd_w_out': dense((nD, N_HEADS * HEAD_DIM, D), N_HEADS * HEAD_DIM),
        'mem_norm_g': gain((D,)),
        'xa_wq': dense((DEPTH, D, XA_HEADS * XA_HEAD_DIM), D),
        'xa_wkv': dense((DEPTH, D, 2 * XA_HEADS * XA_HEAD_DIM), D),
        'xa_wo': dense((DEPTH, XA_HEADS * XA_HEAD_DIM, D), XA_HEADS * XA_HEAD_DIM),
        'router_w': dense((DEPTH, D, N_EXPERTS), D),
        'moe_w_gate': dense((DEPTH, N_EXPERTS, D, EXPERT_FF), D),
        'moe_w_up': dense((DEPTH, N_EXPERTS, D, EXPERT_FF), D),
        'moe_w_down': dense((DEPTH, N_EXPERTS, EXPERT_FF, D), EXPERT_FF),
        'final_norm_g': gain((D,)),
    }


def reference(x, mem, norm_mix_g, norm_xa_g, norm_ffn_g,
              a_w_in, a_sink, a_w_out,
              b_w_in, b_q_norm_g, b_k_norm_g, b_w_out,
              c_w_in, c_q_lat_norm_g, c_kv_lat_norm_g, c_w_uq, c_w_ukv, c_w_out,
              d_w_in, d_rpb, d_w_out,
              mem_norm_g, xa_wq, xa_wkv, xa_wo,
              router_w, moe_w_gate, moe_w_up, moe_w_down, final_norm_g):
    mem_n = _rms_norm(mem, mem_norm_g)
    h = x
    for i in range(DEPTH):
        m, j = i % N_MIXERS, i // N_MIXERS
        xn = _rms_norm(h, norm_mix_g[i])
        if m == 0:
            mix = _mixer_window_sink(xn, a_w_in[j], a_sink[j], a_w_out[j])
        elif m == 1:
            mix = _mixer_axial(xn, b_w_in[j], b_q_norm_g[j], b_k_norm_g[j], b_w_out[j])
        elif m == 2:
            mix = _mixer_mla(xn, c_w_in[j], c_q_lat_norm_g[j], c_kv_lat_norm_g[j], c_w_uq[j], c_w_ukv[j], c_w_out[j])
        else:
            mix = _mixer_neighbourhood(xn, d_w_in[j], d_rpb[j], d_w_out[j])
        h = h + mix
        h = h + _memory_cross_attention(_rms_norm(h, norm_xa_g[i]), mem_n, xa_wq[i], xa_wkv[i], xa_wo[i])
        h = h + _expert_choice_ffn(_rms_norm(h, norm_ffn_g[i]), router_w[i], moe_w_gate[i], moe_w_up[i], moe_w_down[i])
    return _rms_norm(h, final_norm_g)
```

```cpp
#include <hip/hip_runtime.h>
#include <cstdio>
#include <cstdint>

#ifndef MK_SINGLE
#define MK_SINGLE 1
#endif

#ifndef PHMASK
#define PHMASK 0xFFFFFu
#endif
#ifndef ATT2A
#define ATT2A att::attn_unit
#endif
#ifndef ATT2B
#define ATT2B att::attn_unit
#endif
#ifndef ATT2C
#define ATT2C att::attn_unit
#endif
#ifndef ATT2D
#define ATT2D att::attn_unit
#endif
#ifndef SIDE_X
#define SIDE_K1 1
#define SIDE_X 0
#endif
#ifndef PIGGY
#define PIGGY 1
#endif
#ifndef SIDE_DOWN
#define SIDE_DOWN 0
#endif
#ifndef BG_CONVERT
#define BG_CONVERT 0
#endif
#define EN(k) (((PHMASK) >> (k)) & 1u)
#ifndef REP_MASK
#define REP_MASK 0x0u
#endif
#ifndef REP_LMASK
#define REP_LMASK 0xFu
#endif
#ifndef XTRA_BAR
#define XTRA_BAR 0
#endif
#define REPS(k) (((((REP_MASK) >> (k)) & 1u) && (((REP_LMASK) >> (L_)) & 1u)) ? 2 : 1)
#define LAS __attribute__((address_space(3)))
typedef unsigned short bf16_t;
typedef short bf16x8 __attribute__((ext_vector_type(8)));
typedef short s16x4 __attribute__((ext_vector_type(4)));
typedef float f32x4 __attribute__((ext_vector_type(4)));
typedef float f32x16 __attribute__((ext_vector_type(16)));
typedef unsigned u32x4 __attribute__((ext_vector_type(4)));
typedef unsigned u32x2 __attribute__((ext_vector_type(2)));

__device__ __forceinline__ unsigned cvtpk(float lo, float hi) { unsigned r; asm volatile("v_cvt_pk_bf16_f32 %0, %1, %2" : "=v"(r) : "v"(lo), "v"(hi)); return r; }
__device__ __forceinline__ float bf2f(unsigned b) { return __uint_as_float(b << 16); }
__device__ __forceinline__ bf16_t f2bf(float f) { return (bf16_t)(cvtpk(f, f) & 0xffffu); }
template <class TP> __device__ __forceinline__ TP* opaque(TP* p) { unsigned long long v = (unsigned long long)p; asm volatile("" : "+s"(v)); return (TP*)(__attribute__((address_space(1))) TP*)v; }
#define GAS __attribute__((address_space(1)))
__device__ __forceinline__ const float* ldp(volatile LAS unsigned long long* t, int i) { const unsigned long long v = t[i]; const unsigned lo = __builtin_amdgcn_readfirstlane((unsigned)v), hi = __builtin_amdgcn_readfirstlane((unsigned)(v >> 32));
    const GAS float* g = (const GAS float*)(((unsigned long long)hi << 32) | lo); return (const float*)g; }
__device__ __forceinline__ int opq_v(int v) { asm volatile("" : "+v"(v)); return v; }
__device__ __forceinline__ int opq_s(int v) { asm volatile("" : "+s"(v)); return v; }
__device__ __forceinline__ float wave_sum(float v) {
#pragma unroll
    for (int o = 1; o < 64; o <<= 1) v += __shfl_xor(v, o);
    return v;
}

constexpr int NB = 4, SEQ = 2048, T = NB * SEQ, DM = 2048, NH = 16, NKV = 4, HD = 128, GQA_IN = 3072;
constexpr int MLA_IN = 1088, MLA_INP = 1280, MEMT = 256, XAI = 512, NE = 16, CAP = 256, FF = 1024, NSLOT = NB * NE * CAP;
constexpr float EPS = 1e-6f;

constexpr size_t MiB = 1u << 20;
constexpr size_t al256(size_t x) { return (x + 255) & ~(size_t)255; }
constexpr size_t WS_CTL = 0, CTL_BYTES = 64 * 1024;
constexpr size_t WS_TABA = 1 * MiB;
constexpr size_t WS_TABBR = WS_TABA + 2048 * 16 * 2 * 4;
constexpr size_t WS_TABBC = WS_TABBR + 32 * 32 * 2 * 4;
constexpr size_t WS_TABC = WS_TABBC + 64 * 32 * 2 * 4;
constexpr size_t WS_AFF = 2 * MiB;
constexpr size_t WS_IDX = WS_AFF + (size_t)NB * NE * SEQ * 4;
constexpr size_t WS_GATE = WS_IDX + (size_t)NSLOT * 4;
constexpr size_t WS_SLOT = WS_GATE + (size_t)NSLOT * 4;
constexpr size_t WS_SS2 = 3 * MiB;
constexpr size_t WS_RS1 = 2 * MiB + 1280 * 1024, WS_RS3 = WS_RS1 + (size_t)T * 4;
constexpr size_t WS_RSG = WS_RS3 + (size_t)T * 4;
constexpr size_t WS_W = 4 * MiB;
constexpr size_t W_A_IN = WS_W, W_A_OUT = W_A_IN + (size_t)3072 * 2048 * 2, W_B_IN = W_A_OUT + (size_t)2048 * 2048 * 2, W_B_OUT = W_B_IN + (size_t)3072 * 2048 * 2;
constexpr size_t W_D_IN = W_B_OUT + (size_t)2048 * 2048 * 2, W_D_OUT = W_D_IN + (size_t)3072 * 2048 * 2;
constexpr size_t W_C_IN = W_D_OUT + (size_t)2048 * 2048 * 2, W_C_UQ = W_C_IN + (size_t)MLA_INP * 2048 * 2, W_C_UKV = W_C_UQ + (size_t)3072 * 512 * 2, W_C_OUT = W_C_UKV + (size_t)4096 * 512 * 2;
constexpr size_t W_XQ = W_C_OUT + (size_t)2048 * 2048 * 2, W_XKV = W_XQ + (size_t)4 * 512 * 2048 * 2, W_XO = W_XKV + (size_t)4 * 1024 * 2048 * 2;
constexpr size_t W_M1 = W_XO + (size_t)4 * 2048 * 512 * 2, W_M2 = W_M1 + (size_t)64 * 2048 * 2048 * 2, W_END = W_M2 + (size_t)64 * 2048 * 1024 * 2;
constexpr size_t A_H = al256(W_END), A_XN = A_H + (size_t)T * DM * 4, A_QKV = A_XN + (size_t)T * DM * 2, A_KM = A_QKV + (size_t)T * 3072 * 2, A_VM = A_KM + (size_t)T * 3072 * 2;
constexpr size_t A_LAT = A_VM + (size_t)T * 2048 * 2, A_CN = A_LAT + (size_t)T * MLA_INP * 4, A_O = A_CN + (size_t)T * 1024 * 2, A_QX = A_O + (size_t)T * DM * 2, A_OX = A_QX + (size_t)T * XAI * 2;
constexpr size_t A_KVX = A_OX + (size_t)T * XAI * 2, A_MEMN = A_KVX + (size_t)4 * 1024 * 1024 * 2, A_XG = A_MEMN + (size_t)1024 * 2048 * 2, A_HMID = A_XG + (size_t)NSLOT * DM * 2;
constexpr size_t A_Y = A_HMID + (size_t)NSLOT * FF * 2, WS_END = A_Y + (size_t)NSLOT * DM * 2;
constexpr size_t WS_RW = A_XN;
constexpr size_t A_TRASH = A_XG;

constexpr int RING_BYTES = 131072, LDS_BYTES = 163840, LDSCTL_OFF = LDS_BYTES - 1024;

#define XB_TMO      128
#define XB_XCNT(j)  (256  + 64 * (j))
#define XB_XSUB(j)  (1280 + 64 * (j))
#define XB_XGEN(j)  (2304 + 64 * (j))
#define XB_TOP      3328
#define XB_TOPGEN   3392
#define XCD_BAR_WORDS 3456
#define XB_SPIN_CAP (1u << 18)

__device__ __forceinline__ unsigned xb_ld(unsigned* p)              { return __hip_atomic_load(p, __ATOMIC_RELAXED, __HIP_MEMORY_SCOPE_AGENT); }
__device__ __forceinline__ unsigned xb_add(unsigned* p, unsigned v) { return __hip_atomic_fetch_add(p, v, __ATOMIC_RELAXED, __HIP_MEMORY_SCOPE_AGENT); }
__device__ __forceinline__ unsigned xb_xcc_id() { return (unsigned)__builtin_amdgcn_s_getreg((3 << 11) | 20) & 0xFu; }
#define XB_SPIN(cond, bar) do { unsigned _sp = 0; while (cond) { __builtin_amdgcn_s_sleep(1); \
    if ((++_sp & 255u) == 0u) { if (xb_ld(&(bar)[XB_TMO])) break; if (_sp > XB_SPIN_CAP) { atomicAdd(&(bar)[XB_TMO], 1u); break; } } } } while (0)

struct XcdBarrier { unsigned* bar; unsigned x; volatile LAS unsigned* st; };

__device__ __forceinline__ XcdBarrier xcd_barrier_post(unsigned* bar, volatile LAS unsigned* st, const int tid) {
    XcdBarrier b; b.bar = bar; b.x = xb_xcc_id(); b.st = st;
    if (tid == 0) (void)xb_add(&bar[XB_XCNT(b.x)], 1u);
    return b;
}
__device__ __forceinline__ void xcd_barrier_complete(unsigned* bar, unsigned x, unsigned& nloc, unsigned& nx) {
    const unsigned G = gridDim.x * gridDim.y * gridDim.z;
    unsigned sum, cnt, mine, sp = 0u;
    for (;;) {
        sum = 0u; cnt = 0u; mine = 0u;
#pragma unroll
        for (unsigned j = 0; j < 16; ++j) { const unsigned c = xb_ld(&bar[XB_XCNT(j)]); sum += c; cnt += (c > 0u) ? 1u : 0u; mine = (j == x) ? c : mine; }
        if (sum == G) break;
        __builtin_amdgcn_s_sleep(1);
        if ((++sp & 255u) == 0u) { if (xb_ld(&bar[XB_TMO])) break; if (sp > XB_SPIN_CAP) { atomicAdd(&bar[XB_TMO], 1u); break; } }
    }
    nloc = mine > 0u ? mine : 1u; nx = cnt > 0u ? cnt : 1u;
}
__device__ __forceinline__ void xcd_barrier(const XcdBarrier& b, const int tid) {
    asm volatile("s_waitcnt vmcnt(0)" ::: "memory");
    __syncthreads();
    if (tid == 0) {
        unsigned* bar = b.bar;
        __builtin_amdgcn_s_waitcnt(0);
        unsigned nloc = b.st[0], nx = b.st[1];
        if (nloc == 0u) { xcd_barrier_complete(bar, b.x, nloc, nx); b.st[0] = nloc; b.st[1] = nx; }
        const unsigned old = xb_add(&bar[XB_XSUB(b.x)], 1u);
        const unsigned gen = old / nloc;
        if (old + 1u == (gen + 1u) * nloc) {
            __builtin_amdgcn_fence(__ATOMIC_RELEASE, "agent");
            asm volatile("s_waitcnt vmcnt(0)" ::: "memory");
            const unsigned og = xb_add(&bar[XB_TOP], 1u);
            const unsigned tg = og / nx;
            if (og + 1u == (tg + 1u) * nx) xb_add(&bar[XB_TOPGEN], 1u);
            else XB_SPIN(xb_ld(&bar[XB_TOPGEN]) == tg, bar);
            __builtin_amdgcn_fence(__ATOMIC_ACQUIRE, "agent");
            xb_add(&bar[XB_XGEN(b.x)], 1u);
            asm volatile("s_waitcnt vmcnt(0)" ::: "memory");
        } else {
            XB_SPIN(xb_ld(&bar[XB_XGEN(b.x)]) == gen, bar);
            __builtin_amdgcn_fence(__ATOMIC_ACQUIRE, "agent");
            asm volatile("s_waitcnt vmcnt(0)" ::: "memory");
        }
    }
    __syncthreads();
}

namespace pg8 {
constexpr int BM = 256, BK = 64, HALF = 128, HTB = HALF * BK * 2, STAGE_BYTES = 8 * HTB, NXCD = 8, WGM = 8;
__host__ __device__ __forceinline__ int lds_byte(int r, int c) { const int st = (r >> 4) * 2 + (c >> 5), rr = r & 15, cc = c & 31, ob = rr * 64 + cc * 2; return st * 1024 + (ob ^ (((ob >> 9) & 1) << 5)); }
__host__ __device__ __forceinline__ void stage_rc(int b, int& R, int& C) { const int st = b / 1024, sb = b % 1024, swz = sb ^ (((sb >> 9) & 1) << 5); R = (st >> 1) * 16 + swz / 64; C = (st & 1) * 32 + (swz % 64) / 2; }
__host__ __device__ __forceinline__ int perm32(int rho) { const int n = rho >> 4, i = rho & 15; return 8 * (i >> 2) + 4 * n + (i & 3); }

struct Unit { const char* a; const char* b; int pm, pn, aux; };

struct PlainOrder {
    static constexpr bool GATHER = false; const int* rows = nullptr;
    const char* A; const char* Bt; int lda, ldb, nM, nN, nwg, G, c;
    __device__ void init(const void* A_, const void* Bt_, int lda_, int ldb_, int M, int N, int G_, int c_) { A = (const char*)A_; Bt = (const char*)Bt_; lda = lda_; ldb = ldb_; nM = M / BM; nN = N / BM; nwg = nM * nN; G = G_; c = c_; }
    __device__ bool next(int i, Unit& u) const {
        const long L = (long)i * G + c; if (L >= nwg) return false;
        int wgid = (int)L; { const int q = nwg / NXCD, r = nwg % NXCD, xcd = wgid % NXCD, off = wgid / NXCD; wgid = (xcd < r ? xcd * (q + 1) : r * (q + 1) + (xcd - r) * q) + off; }
        const int nig = WGM * nN, gid = wgid / nig, fm = gid * WGM, gsz = (nM - fm) < WGM ? (nM - fm) : WGM;
        u.pm = fm + ((wgid % nig) % gsz); u.pn = (wgid % nig) / gsz;
        u.a = A + (size_t)u.pm * BM * lda * 2; u.b = Bt + (size_t)u.pn * BM * ldb * 2; return true;
    }
};
struct SplitKOrder {
    static constexpr bool GATHER = false; const int* rows = nullptr;
    const char* A; const char* Bt; int lda, ldb, nN, KS, Kc, nwg, G, c;
    __device__ bool next(int i, Unit& u) const {
        const int L = i * G + c; if (L >= nwg) return false;
        const int per = nN * KS; u.pm = L / per; const int r = L % per; u.pn = r / KS; u.aux = r % KS;
        u.a = A + (size_t)u.pm * BM * lda * 2 + (size_t)u.aux * Kc * 2; u.b = Bt + (size_t)u.pn * BM * ldb * 2 + (size_t)u.aux * Kc * 2; return true;
    }
};
struct MoeOrder {
    static constexpr bool GATHER = false; const int* rows = nullptr;
    const char* A; const char* Bt; int lda, ldb, G, vcu; size_t bstride;
    __device__ bool next(int i, Unit& u) const {
        const int L = i * G + vcu; if (L >= 512) return false;
        const int e = L >> 5, b = L & 3, pn = (L & 31) >> 2;
        u.pm = b * 16 + e; u.pn = pn;
        u.a = A + (size_t)u.pm * BM * lda * 2; u.b = Bt + (size_t)e * bstride + (size_t)pn * BM * ldb * 2; return true;
    }
};
struct MoeGatherOrder {
    static constexpr bool GATHER = true; const int* rows;
    const char* A; const char* Bt; int lda, ldb, G, vcu; size_t bstride;
    __device__ bool next(int i, Unit& u) const {
        const int L = i * G + vcu; if (L >= 512) return false;
        const int e = L >> 5, b = L & 3, pn = (L & 31) >> 2;
        u.pm = b * 16 + e; u.pn = pn;
        u.a = A; u.b = Bt + (size_t)e * bstride + (size_t)pn * BM * ldb * 2; return true;
    }
};

__device__ __forceinline__ void st16_wt(void* p, const u32x4 w) { asm volatile("global_store_dwordx4 %0, %1, off sc1\n\ts_nop 1" :: "v"(p), "v"(w)); }
struct EpiBf16 {
    static constexpr bool PERM = true;
    bf16_t* O; int ldc;
    __device__ __forceinline__ void operator()(const f32x4 (&acc)[2][2][4][2], const Unit& u, int wr, int wc, int fr, int fq) const {
        const int row0 = u.pm * BM + wr * 64 + fr, col0 = u.pn * BM + wc * 32 + 8 * fq;
#pragma unroll
        for (int ai = 0; ai < 2; ++ai)
#pragma unroll
            for (int m = 0; m < 4; ++m) { bf16_t* rowp = O + (size_t)(row0 + ai * HALF + m * 16) * ldc + col0;
#pragma unroll
                for (int bj = 0; bj < 2; ++bj) { const f32x4 v0 = acc[ai][bj][m][0], v1 = acc[ai][bj][m][1];
                    u32x4 w; w.x = cvtpk(v0[0], v0[1]); w.y = cvtpk(v0[2], v0[3]); w.z = cvtpk(v1[0], v1[1]); w.w = cvtpk(v1[2], v1[3]);
                    st16_wt(rowp + bj * HALF, w); } }
    }
};
struct EpiMlaKV {
    static constexpr bool PERM = true;
    bf16_t* KM; bf16_t* VM;
    __device__ __forceinline__ void operator()(const f32x4 (&acc)[2][2][4][2], const Unit& u, int wr, int wc, int fr, int fq) const {
        const int row0 = u.pm * BM + wr * 64 + fr, c0 = wc * 32 + 8 * fq;
#pragma unroll
        for (int ai = 0; ai < 2; ++ai)
#pragma unroll
            for (int m = 0; m < 4; ++m) { const size_t row = (size_t)(row0 + ai * HALF + m * 16);
#pragma unroll
                for (int bj = 0; bj < 2; ++bj) { const f32x4 v0 = acc[ai][bj][m][0], v1 = acc[ai][bj][m][1];
                    u32x4 w; w.x = cvtpk(v0[0], v0[1]); w.y = cvtpk(v0[2], v0[3]); w.z = cvtpk(v1[0], v1[1]); w.w = cvtpk(v1[2], v1[3]);
                    bf16_t* p = bj == 0 ? KM + row * 3072 + u.pn * 192 + c0 : VM + row * 2048 + u.pn * 128 + c0;
                    st16_wt(p, w); } }
    }
};
struct EpiF32 {
    static constexpr bool PERM = false;
    float* C; int ldc;
    __device__ __forceinline__ void operator()(const f32x4 (&acc)[2][2][4][2], const Unit& u, int wr, int wc, int fr, int fq) const {
        const int row0 = u.pm * BM + wr * 64 + fr, col0 = u.pn * BM + wc * 32 + 4 * fq;
#pragma unroll
        for (int ai = 0; ai < 2; ++ai)
#pragma unroll
            for (int m = 0; m < 4; ++m) { float* rowp = C + (size_t)(row0 + ai * HALF + m * 16) * ldc + col0;
#pragma unroll
                for (int bj = 0; bj < 2; ++bj)
#pragma unroll
                    for (int n = 0; n < 2; ++n) *(f32x4*)(rowp + bj * HALF + n * 16) = acc[ai][bj][m][n]; }
    }
};
struct EpiResid {
    static constexpr bool PERM = false;
    const float* Hin; float* Hout; int ld;
    __device__ __forceinline__ void operator()(const f32x4 (&acc)[2][2][4][2], const Unit& u, int wr, int wc, int fr, int fq) const {
        const int row0 = u.pm * BM + wr * 64 + fr, col0 = u.pn * BM + wc * 32 + 4 * fq;
#pragma unroll
        for (int ai = 0; ai < 2; ++ai)
#pragma unroll
            for (int m = 0; m < 4; ++m) { const size_t off = (size_t)(row0 + ai * HALF + m * 16) * ld + col0;
                f32x4 r[2][2];
#pragma unroll
                for (int bj = 0; bj < 2; ++bj)
#pragma unroll
                    for (int n = 0; n < 2; ++n) r[bj][n] = *(const f32x4*)(Hin + off + bj * HALF + n * 16);
#pragma unroll
                for (int bj = 0; bj < 2; ++bj)
#pragma unroll
                    for (int n = 0; n < 2; ++n) *(f32x4*)(Hout + off + bj * HALF + n * 16) = r[bj][n] + acc[ai][bj][m][n]; }
    }
};
struct EpiResidHB {
    static constexpr bool PERM = false;
    const float* Hin; float* Hout; bf16_t* HB; float* ss; int ld;
    __device__ __forceinline__ void operator()(const f32x4 (&acc)[2][2][4][2], const Unit& u, int wr, int wc, int fr, int fq) const {
        const int row0 = u.pm * BM + wr * 64 + fr, col0 = u.pn * BM + wc * 32 + 4 * fq;
#pragma unroll
        for (int ai = 0; ai < 2; ++ai)
#pragma unroll
            for (int m = 0; m < 4; ++m) { const int row = row0 + ai * HALF + m * 16; const size_t off = (size_t)row * ld + col0;
                f32x4 r[2][2]; float sq = 0.f;
#pragma unroll
                for (int bj = 0; bj < 2; ++bj)
#pragma unroll
                    for (int n = 0; n < 2; ++n) r[bj][n] = *(const f32x4*)(Hin + off + bj * HALF + n * 16);
#pragma unroll
                for (int bj = 0; bj < 2; ++bj)
#pragma unroll
                    for (int n = 0; n < 2; ++n) { const f32x4 v = r[bj][n] + acc[ai][bj][m][n]; *(f32x4*)(Hout + off + bj * HALF + n * 16) = v;
                        u32x2 w; w.x = cvtpk(v[0], v[1]); w.y = cvtpk(v[2], v[3]); *(u32x2*)(HB + off + bj * HALF + n * 16) = w;
                        sq += (v[0] * v[0] + v[1] * v[1]) + (v[2] * v[2] + v[3] * v[3]); }
                sq += __shfl_xor(sq, 16); sq += __shfl_xor(sq, 32);
                if (fq == 0) ss[(size_t)row * 32 + u.pn * 4 + wc] = sq; }
    }
};
struct EpiBf16RS {
    static constexpr bool PERM = true;
    bf16_t* O; int ldc; const float* ss;
    __device__ __forceinline__ void operator()(const f32x4 (&acc)[2][2][4][2], const Unit& u, int wr, int wc, int fr, int fq) const {
        const int row0 = u.pm * BM + wr * 64 + fr, col0 = u.pn * BM + wc * 32 + 8 * fq;
#pragma unroll
        for (int ai = 0; ai < 2; ++ai)
#pragma unroll
            for (int m = 0; m < 4; ++m) { const int row = row0 + ai * HALF + m * 16; float sq = 0.f;
#pragma unroll
                for (int i = 0; i < 8; ++i) { const f32x4 p = *(const f32x4*)(ss + (size_t)row * 32 + 4 * i); sq += (p[0] + p[1]) + (p[2] + p[3]); }
                const float rs = 1.0f / sqrtf(sq * (1.0f / DM) + EPS); bf16_t* rowp = O + (size_t)row * ldc + col0;
#pragma unroll
                for (int bj = 0; bj < 2; ++bj) { const f32x4 v0 = acc[ai][bj][m][0] * rs, v1 = acc[ai][bj][m][1] * rs;
                    u32x4 w; w.x = cvtpk(v0[0], v0[1]); w.y = cvtpk(v0[2], v0[3]); w.z = cvtpk(v1[0], v1[1]); w.w = cvtpk(v1[2], v1[3]);
                    st16_wt(rowp + bj * HALF, w); } }
    }
};
struct EpiBf16RS1 {
    static constexpr bool PERM = true;
    bf16_t* O; int ldc; const float* rs;
    __device__ __forceinline__ void operator()(const f32x4 (&acc)[2][2][4][2], const Unit& u, int wr, int wc, int fr, int fq) const {
        const int row0 = u.pm * BM + wr * 64 + fr, col0 = u.pn * BM + wc * 32 + 8 * fq;
#pragma unroll
        for (int ai = 0; ai < 2; ++ai)
#pragma unroll
            for (int m = 0; m < 4; ++m) { const int row = row0 + ai * HALF + m * 16; const float r = rs[row]; bf16_t* rowp = O + (size_t)row * ldc + col0;
#pragma unroll
                for (int bj = 0; bj < 2; ++bj) { const f32x4 v0 = acc[ai][bj][m][0] * r, v1 = acc[ai][bj][m][1] * r;
                    u32x4 w; w.x = cvtpk(v0[0], v0[1]); w.y = cvtpk(v0[2], v0[3]); w.z = cvtpk(v1[0], v1[1]); w.w = cvtpk(v1[2], v1[3]);
                    st16_wt(rowp + bj * HALF, w); } }
    }
};
struct EpiF32RS1 {
    static constexpr bool PERM = false;
    float* C; int ldc; const float* rs;
    __device__ __forceinline__ void operator()(const f32x4 (&acc)[2][2][4][2], const Unit& u, int wr, int wc, int fr, int fq) const {
        const int row0 = u.pm * BM + wr * 64 + fr, col0 = u.pn * BM + wc * 32 + 4 * fq;
#pragma unroll
        for (int ai = 0; ai < 2; ++ai)
#pragma unroll
            for (int m = 0; m < 4; ++m) { const int row = row0 + ai * HALF + m * 16; const float r = rs[row]; float* rowp = C + (size_t)row * ldc + col0;
#pragma unroll
                for (int bj = 0; bj < 2; ++bj)
#pragma unroll
                    for (int n = 0; n < 2; ++n) *(f32x4*)(rowp + bj * HALF + n * 16) = acc[ai][bj][m][n] * r; }
    }
};
template <bool WITH_SS> struct EpiResidB16 {
    static constexpr bool PERM = true;
    const bf16_t* Hin; bf16_t* Hout; float* ss; int ld;
    __device__ __forceinline__ void operator()(const f32x4 (&acc)[2][2][4][2], const Unit& u, int wr, int wc, int fr, int fq) const {
        const int row0 = u.pm * BM + wr * 64 + fr, col0 = u.pn * BM + wc * 32 + 8 * fq;
#pragma unroll
        for (int ai = 0; ai < 2; ++ai)
#pragma unroll
            for (int m = 0; m < 4; ++m) { const int row = row0 + ai * HALF + m * 16; const size_t off = (size_t)row * ld + col0;
                u32x4 h[2]; float sq = 0.f;
#pragma unroll
                for (int bj = 0; bj < 2; ++bj) h[bj] = *(const u32x4*)(Hin + off + bj * HALF);
#pragma unroll
                for (int bj = 0; bj < 2; ++bj) { const f32x4 a0 = acc[ai][bj][m][0], a1 = acc[ai][bj][m][1];
                    const float v0 = bf2f(h[bj].x & 0xffffu) + a0[0], v1 = bf2f(h[bj].x >> 16) + a0[1], v2 = bf2f(h[bj].y & 0xffffu) + a0[2], v3 = bf2f(h[bj].y >> 16) + a0[3];
                    const float v4 = bf2f(h[bj].z & 0xffffu) + a1[0], v5 = bf2f(h[bj].z >> 16) + a1[1], v6 = bf2f(h[bj].w & 0xffffu) + a1[2], v7 = bf2f(h[bj].w >> 16) + a1[3];
                    u32x4 w; w.x = cvtpk(v0, v1); w.y = cvtpk(v2, v3); w.z = cvtpk(v4, v5); w.w = cvtpk(v6, v7);
                    st16_wt(Hout + off + bj * HALF, w);
                    if (WITH_SS) sq += ((v0 * v0 + v1 * v1) + (v2 * v2 + v3 * v3)) + ((v4 * v4 + v5 * v5) + (v6 * v6 + v7 * v7)); }
                if (WITH_SS) { sq += __shfl_xor(sq, 16); sq += __shfl_xor(sq, 32); if (fq == 0) ss[(size_t)row * 32 + u.pn * 4 + wc] = sq; } }
    }
};
struct EpiBf16Slab {
    static constexpr bool PERM = true;
    bf16_t* O; int ldc; size_t slab;
    __device__ __forceinline__ void operator()(const f32x4 (&acc)[2][2][4][2], const Unit& u, int wr, int wc, int fr, int fq) const {
        const int row0 = u.pm * BM + wr * 64 + fr, col0 = u.pn * BM + wc * 32 + 8 * fq; bf16_t* Os = O + (size_t)u.aux * slab;
#pragma unroll
        for (int ai = 0; ai < 2; ++ai)
#pragma unroll
            for (int m = 0; m < 4; ++m) { bf16_t* rowp = Os + (size_t)(row0 + ai * HALF + m * 16) * ldc + col0;
#pragma unroll
                for (int bj = 0; bj < 2; ++bj) { const f32x4 v0 = acc[ai][bj][m][0], v1 = acc[ai][bj][m][1];
                    u32x4 w; w.x = cvtpk(v0[0], v0[1]); w.y = cvtpk(v0[2], v0[3]); w.z = cvtpk(v1[0], v1[1]); w.w = cvtpk(v1[2], v1[3]);
                    st16_wt(rowp + bj * HALF, w); } }
    }
};
struct EpiBf16SlabRS {
    static constexpr bool PERM = true;
    bf16_t* O; int ldc; size_t slab; const float* ss;
    __device__ __forceinline__ void operator()(const f32x4 (&acc)[2][2][4][2], const Unit& u, int wr, int wc, int fr, int fq) const {
        const int row0 = u.pm * BM + wr * 64 + fr, col0 = u.pn * BM + wc * 32 + 8 * fq; bf16_t* Os = O + (size_t)u.aux * slab;
#pragma unroll
        for (int ai = 0; ai < 2; ++ai)
#pragma unroll
            for (int m = 0; m < 4; ++m) { const int row = row0 + ai * HALF + m * 16; float sq = 0.f;
#pragma unroll
                for (int i = 0; i < 8; ++i) { const f32x4 p = *(const f32x4*)(ss + (size_t)row * 32 + 4 * i); sq += (p[0] + p[1]) + (p[2] + p[3]); }
                const float rs = 1.0f / sqrtf(sq * (1.0f / DM) + EPS); bf16_t* rowp = Os + (size_t)row * ldc + col0;
#pragma unroll
                for (int bj = 0; bj < 2; ++bj) { const f32x4 v0 = acc[ai][bj][m][0] * rs, v1 = acc[ai][bj][m][1] * rs;
                    u32x4 w; w.x = cvtpk(v0[0], v0[1]); w.y = cvtpk(v0[2], v0[3]); w.z = cvtpk(v1[0], v1[1]); w.w = cvtpk(v1[2], v1[3]);
                    st16_wt(rowp + bj * HALF, w); } }
    }
};
__device__ __forceinline__ float silu_mul(float g, float u) { return g * u * __builtin_amdgcn_rcpf(1.0f + __expf(-g)); }
struct EpiSwiGLU {
    static constexpr bool PERM = true;
    bf16_t* Hm; const float* rs; const float* gate;
    __device__ __forceinline__ void operator()(const f32x4 (&acc)[2][2][4][2], const Unit& u, int wr, int wc, int fr, int fq) const {
        const int row0 = u.pm * BM + wr * 64 + fr, col0 = u.pn * HALF + wc * 32 + 8 * fq;
#pragma unroll
        for (int ai = 0; ai < 2; ++ai)
#pragma unroll
            for (int m = 0; m < 4; ++m) { const int row = row0 + ai * HALF + m * 16; const float r = rs[row], gt = gate[row]; bf16_t* rowp = Hm + (size_t)row * FF + col0;
                const f32x4 g0 = acc[ai][0][m][0] * r, g1 = acc[ai][0][m][1] * r, u0 = acc[ai][1][m][0] * r, u1 = acc[ai][1][m][1] * r;
                u32x4 w; w.x = cvtpk(silu_mul(g0[0], u0[0]) * gt, silu_mul(g0[1], u0[1]) * gt); w.y = cvtpk(silu_mul(g0[2], u0[2]) * gt, silu_mul(g0[3], u0[3]) * gt);
                w.z = cvtpk(silu_mul(g1[0], u1[0]) * gt, silu_mul(g1[1], u1[1]) * gt); w.w = cvtpk(silu_mul(g1[2], u1[2]) * gt, silu_mul(g1[3], u1[3]) * gt);
                st16_wt(rowp, w); }
    }
};
struct EpiGate {
    static constexpr bool PERM = true;
    bf16_t* Y; const float* gate;
    __device__ __forceinline__ void operator()(const f32x4 (&acc)[2][2][4][2], const Unit& u, int wr, int wc, int fr, int fq) const {
        const int row0 = u.pm * BM + wr * 64 + fr, col0 = u.pn * BM + wc * 32 + 8 * fq;
#pragma unroll
        for (int ai = 0; ai < 2; ++ai)
#pragma unroll
            for (int m = 0; m < 4; ++m) { const int row = row0 + ai * HALF + m * 16; const float gs = gate[row]; bf16_t* rowp = Y + (size_t)row * DM + col0;
#pragma unroll
                for (int bj = 0; bj < 2; ++bj) { const f32x4 v0 = acc[ai][bj][m][0] * gs, v1 = acc[ai][bj][m][1] * gs;
                    u32x4 w; w.x = cvtpk(v0[0], v0[1]); w.y = cvtpk(v0[2], v0[3]); w.z = cvtpk(v1[0], v1[1]); w.w = cvtpk(v1[2], v1[3]);
                    st16_wt(rowp + bj * HALF, w); } }
    }
};

template <class Epi, class Sched, bool ALIGN_EPI = true, bool SP2 = true>
__device__ __forceinline__ void gemm_phase(LAS unsigned char* lds, const int tid_in, const int K, const int lda, const int ldb, const Sched& S, const Epi& E) {
    const int tid = opq_v(tid_in);
    const int wid = __builtin_amdgcn_readfirstlane(tid >> 6), lane = tid & 63, wr = wid >> 2, wc = wid & 3, fr = lane & 15, fq = lane >> 4;
    const int nt = K / BK;
    unsigned voffB[2];
#pragma unroll
    for (int i = 0; i < 2; ++i) { int R, C; stage_rc(tid * 16 + i * 8192, R, C); const int Rb = Epi::PERM ? ((R & ~31) + perm32(R & 31)) : R;
        voffB[i] = (unsigned)(Rb * ldb + C) * 2u; }
    const size_t kstep = (size_t)(BK * 2);
    const size_t hstepB = (size_t)HALF * ldb * 2;
    unsigned cvA[2][2], nvA[2][2];
#define PG8_FILLA(dst, unit) do { _Pragma("unroll") for (int _h = 0; _h < 2; ++_h) _Pragma("unroll") for (int _i = 0; _i < 2; ++_i) { int _R, _C; stage_rc(tid * 16 + _i * 8192, _R, _C); \
        if constexpr (Sched::GATHER) dst[_h][_i] = (unsigned)S.rows[(unit).pm * BM + _h * HALF + _R] * (unsigned)(lda * 2) + (unsigned)(_C * 2); \
        else dst[_h][_i] = (unsigned)((_h * HALF + _R) * lda + _C) * 2u; } } while (0)
    const unsigned ldsw = (unsigned)wid * 1024u;
    const int aoff = lds_byte(wr * 64 + fr, fq * 8), boff = lds_byte(wc * 32 + fr, fq * 8);
#define PG8_SA(b, h) (((b) * 2 + (h)) * HTB)
#define PG8_SB(b, h) ((4 + (b) * 2 + (h)) * HTB)
#define PG8_STAGE(bufoff, gbase, voff) do { _Pragma("unroll") for (int _i = 0; _i < 2; ++_i) \
        __builtin_amdgcn_global_load_lds((const unsigned*)((const char*)(gbase) + (voff)[_i]), (LAS unsigned*)(lds + (bufoff) + ldsw + _i * 8192), 16, 0, 0); } while (0)
#define PG8_LDA(dst, b, h) do { _Pragma("unroll") for (int m = 0; m < 4; ++m) _Pragma("unroll") for (int k = 0; k < 2; ++k) dst[m][k] = *(const LAS bf16x8*)(lds + PG8_SA(b, h) + aoff + m * 2048 + k * 1024); } while (0)
#define PG8_LDB(dst, b, h) do { _Pragma("unroll") for (int n = 0; n < 2; ++n) _Pragma("unroll") for (int k = 0; k < 2; ++k) dst[n][k] = *(const LAS bf16x8*)(lds + PG8_SB(b, h) + boff + n * 2048 + k * 1024); } while (0)
#define PG8_MMA(ai, bj, At, Bt) do { __builtin_amdgcn_s_setprio(1); _Pragma("unroll") for (int m = 0; m < 4; ++m) _Pragma("unroll") for (int n = 0; n < 2; ++n) _Pragma("unroll") for (int k = 0; k < 2; ++k) \
        acc[ai][bj][m][n] = __builtin_amdgcn_mfma_f32_16x16x32_bf16(Bt[n][k], At[m][k], acc[ai][bj][m][n], 0, 0, 0); __builtin_amdgcn_s_setprio(0); } while (0)
#define PG8_WAIT_V(n) asm volatile("s_waitcnt vmcnt(" #n ")" ::: "memory")
#define PG8_WAIT_L(n) asm volatile("s_waitcnt lgkmcnt(" #n ")" ::: "memory")
#define PG8_BAR __builtin_amdgcn_s_barrier()
#define PG8_SCHED __builtin_amdgcn_sched_barrier(0)
    Unit cur, nxt; int ui = 0;
    if (!S.next(0, cur)) return;
    f32x4 acc[2][2][4][2];
#pragma unroll
    for (int a = 0; a < 2; ++a)
#pragma unroll
        for (int b = 0; b < 2; ++b)
#pragma unroll
            for (int m = 0; m < 4; ++m)
#pragma unroll
                for (int n = 0; n < 2; ++n) acc[a][b][m][n] = (f32x4){0.f, 0.f, 0.f, 0.f};
    bf16x8 At[4][2], B0[2][2], B1[2][2];
    const char* cA = cur.a; const char* cB = cur.b;
    PG8_FILLA(cvA, cur);
    if constexpr (Sched::GATHER) asm volatile("s_waitcnt vmcnt(0)" ::: "memory");
    if constexpr (SP2) {
        PG8_STAGE(PG8_SB(0, 0), cB, voffB); PG8_STAGE(PG8_SB(0, 1), cB + hstepB, voffB); PG8_STAGE(PG8_SA(0, 0), cA, cvA[0]); PG8_STAGE(PG8_SA(0, 1), cA, cvA[1]);
        if (wr == 1) PG8_BAR;
        PG8_WAIT_V(2); PG8_BAR;
        PG8_STAGE(PG8_SB(1, 0), cB + kstep, voffB); PG8_STAGE(PG8_SA(1, 0), cA + kstep, cvA[0]); PG8_STAGE(PG8_SB(1, 1), cB + hstepB + kstep, voffB);
        PG8_WAIT_V(6); PG8_BAR;
    } else {
        PG8_STAGE(PG8_SB(0, 0), cB, voffB); PG8_STAGE(PG8_SA(0, 0), cA, cvA[0]); PG8_STAGE(PG8_SB(0, 1), cB + hstepB, voffB); PG8_STAGE(PG8_SA(0, 1), cA, cvA[1]);
        if (wr == 1) PG8_BAR;
        PG8_WAIT_V(4); PG8_BAR;
        PG8_STAGE(PG8_SB(1, 0), cB + kstep, voffB); PG8_STAGE(PG8_SA(1, 0), cA + kstep, cvA[0]); PG8_STAGE(PG8_SB(1, 1), cB + hstepB + kstep, voffB);
        PG8_WAIT_V(6); PG8_BAR;
    }
    for (;;) {
        const bool has_next = S.next(ui + 1, nxt);
        const char* nA = has_next ? nxt.a : cA; const char* nB = has_next ? nxt.b : cB;
        if constexpr (Sched::GATHER) {
            if (has_next) { PG8_FILLA(nvA, nxt); asm volatile("s_waitcnt vmcnt(0)" ::: "memory"); }
            else {
#pragma unroll
                for (int _h = 0; _h < 2; ++_h)
#pragma unroll
                    for (int _i = 0; _i < 2; ++_i) nvA[_h][_i] = cvA[_h][_i]; }
        }
        for (int t = 0; t < nt; t += 2) {
            const bool last = (t == nt - 2);
            const char* a1 = cA + (size_t)(t + 1) * kstep;
            const char* a2 = last ? nA : cA + (size_t)(t + 2) * kstep; const char* b2 = last ? nB : cB + (size_t)(t + 2) * kstep;
            const char* a3 = a2 + kstep; const char* b3 = b2 + kstep;
            unsigned xa0[2], xa1[2];
            if constexpr (Sched::GATHER) {
#pragma unroll
                for (int _i = 0; _i < 2; ++_i) { xa0[_i] = last ? nvA[0][_i] : cvA[0][_i]; xa1[_i] = last ? nvA[1][_i] : cvA[1][_i]; }
            } else {
#pragma unroll
                for (int _i = 0; _i < 2; ++_i) { xa0[_i] = cvA[0][_i]; xa1[_i] = cvA[1][_i]; }
            }
            if constexpr (SP2) {
            PG8_LDB(B0, 0, 0); PG8_LDB(B1, 0, 1); PG8_SCHED; PG8_LDA(At, 0, 0); PG8_STAGE(PG8_SA(1, 1), a1, cvA[1]);
            PG8_WAIT_V(8); PG8_WAIT_L(0); PG8_BAR; PG8_MMA(0, 0, At, B0); PG8_MMA(0, 1, At, B1); PG8_BAR; PG8_SCHED;
            PG8_LDA(At, 0, 1); PG8_STAGE(PG8_SB(0, 0), b2, voffB); PG8_STAGE(PG8_SB(0, 1), b2 + hstepB, voffB); PG8_STAGE(PG8_SA(0, 0), a2, xa0);
            PG8_WAIT_V(8); PG8_WAIT_L(0); PG8_BAR; PG8_MMA(1, 0, At, B0); PG8_MMA(1, 1, At, B1); PG8_BAR; PG8_SCHED;
            PG8_LDB(B0, 1, 0); PG8_LDB(B1, 1, 1); PG8_SCHED; PG8_LDA(At, 1, 0); PG8_STAGE(PG8_SA(0, 1), a2, xa1);
            PG8_WAIT_V(8); PG8_WAIT_L(0); PG8_BAR; PG8_MMA(0, 0, At, B0); PG8_MMA(0, 1, At, B1); PG8_BAR; PG8_SCHED;
            PG8_LDA(At, 1, 1); PG8_STAGE(PG8_SB(1, 0), b3, voffB); PG8_STAGE(PG8_SB(1, 1), b3 + hstepB, voffB); PG8_STAGE(PG8_SA(1, 0), a3, xa0);
            PG8_WAIT_V(8); PG8_WAIT_L(0); PG8_BAR; PG8_MMA(1, 0, At, B0); PG8_MMA(1, 1, At, B1); PG8_BAR; PG8_SCHED;
            } else {
            PG8_LDB(B0, 0, 0); PG8_SCHED; PG8_LDA(At, 0, 0); PG8_STAGE(PG8_SA(1, 1), a1, cvA[1]);
            PG8_WAIT_L(8); PG8_BAR; PG8_WAIT_L(0); PG8_MMA(0, 0, At, B0); PG8_BAR; PG8_SCHED;
            PG8_LDB(B1, 0, 1); PG8_STAGE(PG8_SB(0, 0), b2, voffB);
            PG8_BAR; PG8_WAIT_L(0); PG8_MMA(0, 1, At, B1); PG8_BAR;
            PG8_LDA(At, 0, 1); PG8_STAGE(PG8_SA(0, 0), a2, xa0);
            PG8_BAR; PG8_WAIT_L(0); PG8_MMA(1, 0, At, B0); PG8_BAR; PG8_SCHED;
            PG8_STAGE(PG8_SB(0, 1), b2 + hstepB, voffB);
            PG8_WAIT_V(6); PG8_BAR; PG8_MMA(1, 1, At, B1); PG8_BAR;
            PG8_LDB(B0, 1, 0); PG8_SCHED; PG8_LDA(At, 1, 0); PG8_STAGE(PG8_SA(0, 1), a2, xa1);
            PG8_WAIT_L(8); PG8_BAR; PG8_WAIT_L(0); PG8_MMA(0, 0, At, B0); PG8_BAR; PG8_SCHED;
            PG8_LDB(B1, 1, 1); PG8_STAGE(PG8_SB(1, 0), b3, voffB);
            PG8_BAR; PG8_WAIT_L(0); PG8_MMA(0, 1, At, B1); PG8_BAR;
            PG8_LDA(At, 1, 1); PG8_STAGE(PG8_SA(1, 0), a3, xa0);
            PG8_BAR; PG8_WAIT_L(0); PG8_MMA(1, 0, At, B0); PG8_BAR; PG8_SCHED;
            PG8_STAGE(PG8_SB(1, 1), b3 + hstepB, voffB);
            PG8_WAIT_V(6); PG8_BAR; PG8_MMA(1, 1, At, B1); PG8_BAR;
            }
        }
        if constexpr (ALIGN_EPI) { if (wr == 0) PG8_BAR; }
        E(acc, cur, wr, wc, fr, fq);
        if (!has_next) break;
#pragma unroll
        for (int a = 0; a < 2; ++a)
#pragma unroll
            for (int b = 0; b < 2; ++b)
#pragma unroll
                for (int m = 0; m < 4; ++m)
#pragma unroll
                    for (int n = 0; n < 2; ++n) acc[a][b][m][n] = (f32x4){0.f, 0.f, 0.f, 0.f};
        cur = nxt; cA = nA; cB = nB; ++ui;
        if constexpr (Sched::GATHER) {
#pragma unroll
            for (int _h = 0; _h < 2; ++_h)
#pragma unroll
                for (int _i = 0; _i < 2; ++_i) cvA[_h][_i] = nvA[_h][_i]; }
        if constexpr (ALIGN_EPI) { if (wr == 1) PG8_BAR; }
    }
    PG8_WAIT_V(0);
    if constexpr (!ALIGN_EPI) { if (wr == 0) PG8_BAR; }
    PG8_BAR;
#undef PG8_FILLA
#undef PG8_SA
#undef PG8_SB
#undef PG8_STAGE
#undef PG8_LDA
#undef PG8_LDB
#undef PG8_MMA
#undef PG8_WAIT_V
#undef PG8_WAIT_L
#undef PG8_BAR
#undef PG8_SCHED
}
}


namespace bgw {
constexpr int IPL = 48 * 1024;
struct Item { const float* src; const float* gk; bf16_t* dst; int N, K, k0, n0, drow0; };
struct NoWork { __device__ __forceinline__ void step_a(int) {} __device__ __forceinline__ void step_b(int) {} };
struct Work {
    int cur, end, half, kind, pending;
    unsigned char* ws; volatile LAS unsigned long long* ptab; LAS float* scr;
    f32x4 r0, r1, r2, r3;
    __device__ __forceinline__ Item decode(int idx) const {
        const int id = kind == 1 ? 2 * 16384 + idx : (kind == 3 ? 3 * IPL + 2 * 16384 + idx : (idx < IPL ? IPL + idx : 2 * IPL + 2 * 16384 + (kind == 4 ? 8192 : 0) + (idx - IPL)));
        const int l = id / IPL, rr = id % IPL, fam = rr >> 14, mat = l * 16 + ((rr >> 10) & 15), it = rr & 1023; Item t;
        if (fam < 2) { t.n0 = (it & 31) * 32; t.k0 = 64 * (it >> 5); t.src = ldp(ptab, 26 + fam) + (size_t)mat * 2048 * 1024; t.N = 1024; t.dst = (bf16_t*)(ws + W_M1) + (size_t)mat * 2048 * 2048; t.K = 2048;
            t.drow0 = (t.n0 >> 7) * 256 + (t.n0 & 127) + (fam == 1 ? 128 : 0); t.gk = ldp(ptab, 4) + l * DM; }
        else { t.n0 = (it & 63) * 32; t.k0 = 64 * (it >> 6); t.src = ldp(ptab, 28) + (size_t)mat * 1024 * 2048; t.N = 2048; t.dst = (bf16_t*)(ws + W_M2) + (size_t)mat * 2048 * 1024; t.K = 1024; t.drow0 = t.n0; t.gk = nullptr; }
        return t;
    }
    __device__ __forceinline__ void step_a(int lane) {
        if (cur >= end) return;
        pending = 1;
        const Item t = decode(cur); const int krow = lane >> 3, n4 = lane & 7;
        const float* p = t.src + (size_t)(t.k0 + 32 * half + krow) * t.N + t.n0 + 4 * n4; const size_t st = (size_t)8 * t.N;
        r0 = __builtin_nontemporal_load((const f32x4*)p); r1 = __builtin_nontemporal_load((const f32x4*)(p + st));
        r2 = __builtin_nontemporal_load((const f32x4*)(p + 2 * st)); r3 = __builtin_nontemporal_load((const f32x4*)(p + 3 * st));
    }
    __device__ __forceinline__ void step_b(int lane) {
        if (!pending) return;
        pending = 0;
        const int krow = lane >> 3, n4 = lane & 7;
        { LAS float* p = scr + (32 * half + krow) * 33 + 4 * n4;
          p[0] = r0.x; p[1] = r0.y; p[2] = r0.z; p[3] = r0.w; p[8 * 33 + 0] = r1.x; p[8 * 33 + 1] = r1.y; p[8 * 33 + 2] = r1.z; p[8 * 33 + 3] = r1.w;
          p[16 * 33 + 0] = r2.x; p[16 * 33 + 1] = r2.y; p[16 * 33 + 2] = r2.z; p[16 * 33 + 3] = r2.w; p[24 * 33 + 0] = r3.x; p[24 * 33 + 1] = r3.y; p[24 * 33 + 2] = r3.z; p[24 * 33 + 3] = r3.w; }
        if (half) { const Item t = decode(cur); const int c = lane & 7;
            f32x4 g0 = {1.f, 1.f, 1.f, 1.f}, g1 = {1.f, 1.f, 1.f, 1.f}; if (t.gk) { g0 = *(const f32x4*)(t.gk + t.k0 + 8 * c); g1 = *(const f32x4*)(t.gk + t.k0 + 8 * c + 4); }
#pragma unroll
            for (int j = 0; j < 4; ++j) { const int n = (lane >> 3) + 8 * j; const LAS float* s = scr + (8 * c) * 33 + n;
                u32x4 o; o.x = cvtpk(s[0 * 33] * g0[0], s[1 * 33] * g0[1]); o.y = cvtpk(s[2 * 33] * g0[2], s[3 * 33] * g0[3]); o.z = cvtpk(s[4 * 33] * g1[0], s[5 * 33] * g1[1]); o.w = cvtpk(s[6 * 33] * g1[2], s[7 * 33] * g1[3]);
                __builtin_nontemporal_store(o, (u32x4*)(t.dst + (size_t)(t.drow0 + n) * t.K + t.k0 + 8 * c)); }
            cur = cur + 1; }
        half ^= 1;
    }
};
}

namespace att {
constexpr int NW = 8, QBLK = 32, KVBLK = 64;
constexpr float THR = 8.f;
#define SBAR() __builtin_amdgcn_sched_barrier(0)
__device__ __forceinline__ int crow(int r, int hi) { return (r & 3) + 8 * (r >> 2) + 4 * hi; }

__device__ __forceinline__ void partialSM(f32x16& p0, f32x16& p1, float& m_reg, float& mn, float& alpha, const float C, const float thr_raw) {
  float pmax = p0[0];
#pragma unroll
  for (int r = 1; r < 16; ++r) pmax = fmaxf(pmax, p0[r]);
#pragma unroll
  for (int r = 0; r < 16; ++r) pmax = fmaxf(pmax, p1[r]);
  { auto rr = __builtin_amdgcn_permlane32_swap(__float_as_uint(pmax), __float_as_uint(pmax), false, false);
    pmax = fmaxf(__uint_as_float(rr[0]), __uint_as_float(rr[1])); }
  if (__builtin_expect(__all(pmax - m_reg <= thr_raw), 1)) { mn = m_reg; alpha = 1.f; }
  else { mn = fmaxf(m_reg, pmax); alpha = __builtin_amdgcn_exp2f((m_reg - mn) * C); m_reg = mn; }
  const float mnC = -mn * C;
#pragma unroll
  for (int r = 0; r < 16; ++r) p0[r] = fmaf(p0[r], C, mnC);
#pragma unroll
  for (int r = 0; r < 16; ++r) p1[r] = fmaf(p1[r], C, mnC);
#pragma unroll
  for (int r = 0; r < 16; ++r) p0[r] = __builtin_amdgcn_exp2f(p0[r]);
}
__device__ __forceinline__ void finishSM(f32x16& p0, f32x16& p1, float alpha, float& l_reg, bf16x8& pa0, bf16x8& pa1, bf16x8& pa2, bf16x8& pa3) {
#pragma unroll
  for (int r = 0; r < 16; ++r) p1[r] = __builtin_amdgcn_exp2f(p1[r]);
  float ps = 0;
#pragma unroll
  for (int r = 0; r < 16; ++r) ps += p0[r];
#pragma unroll
  for (int r = 0; r < 16; ++r) ps += p1[r];
  { auto rr = __builtin_amdgcn_permlane32_swap(__float_as_uint(ps), __float_as_uint(ps), false, false);
    ps = __uint_as_float(rr[0]) + __uint_as_float(rr[1]); }
  l_reg = l_reg * alpha + ps;
#define PK4(P, BASE, OUT) do { unsigned a0 = cvtpk(P[BASE + 0], P[BASE + 1]), a1 = cvtpk(P[BASE + 2], P[BASE + 3]);   \
    unsigned b0 = cvtpk(P[BASE + 4], P[BASE + 5]), b1 = cvtpk(P[BASE + 6], P[BASE + 7]);                              \
    auto r0 = __builtin_amdgcn_permlane32_swap(a0, b0, false, false); auto r1 = __builtin_amdgcn_permlane32_swap(a1, b1, false, false); \
    u32x4 w = {r0[0], r1[0], r0[1], r1[1]}; OUT = *reinterpret_cast<bf16x8*>(&w); } while (0)
  PK4(p0, 0, pa0); PK4(p0, 8, pa1); PK4(p1, 0, pa2); PK4(p1, 8, pa3);
#undef PK4
}
template <int DK> __device__ __forceinline__ int kswz(int row, int colB) { return row * (DK * 2 + 16) + colB; }
template <int DK>
__device__ __forceinline__ void qkt(f32x16& p0, f32x16& p1, const char* Ks, const bf16x8* qr, int r32, int hi) {
  p0 = f32x16{}; p1 = f32x16{};
#pragma unroll
  for (int d0 = 0; d0 < DK / 16; ++d0) { const int cb = (d0 * 16 + hi * 8) * 2;
    const bf16x8 b0 = *reinterpret_cast<const bf16x8*>(Ks + kswz<DK>(r32, cb));
    const bf16x8 b1 = *reinterpret_cast<const bf16x8*>(Ks + kswz<DK>(32 + r32, cb));
    p0 = __builtin_amdgcn_mfma_f32_32x32x16_bf16(b0, qr[d0], p0, 0, 0, 0);
    p1 = __builtin_amdgcn_mfma_f32_32x32x16_bf16(b1, qr[d0], p1, 0, 0, 0); }
}
__device__ __forceinline__ int v_st(int k, int c) { const int kk = (k & ~0xC) | ((k & 4) << 1) | ((k & 8) >> 1); return ((kk >> 3) * 4 + (c >> 5)) * 512 + ((kk & 7) * 32 + (c & 31)) * 2; }
__device__ __forceinline__ int v_rd_base(int lane) { return ((lane & 3) << 3) | (((lane >> 2) & 3) << 6) | (((lane >> 4) & 1) << 5) | (((lane >> 5) & 1) << 8); }
constexpr int v_rd_off(int d0, int ks, int half) { return d0 * 512 + ks * 4096 + half * 2048; }
template <int OFF> __device__ __forceinline__ s16x4 tr_read(int vb) {
  s16x4 r; asm volatile("ds_read_b64_tr_b16 %0, %1 offset:%2" : "=&v"(r) : "v"(vb), "i"(OFF) : "memory"); return r;
}
template <int D0> __device__ __forceinline__ void pv_one(f32x16& od, int vb, bf16x8 pa0, bf16x8 pa1, bf16x8 pa2, bf16x8 pa3) {
  const s16x4 l0 = tr_read<v_rd_off(D0, 0, 0)>(vb), h0 = tr_read<v_rd_off(D0, 0, 1)>(vb), l1 = tr_read<v_rd_off(D0, 1, 0)>(vb), h1 = tr_read<v_rd_off(D0, 1, 1)>(vb);
  const s16x4 l2 = tr_read<v_rd_off(D0, 2, 0)>(vb), h2 = tr_read<v_rd_off(D0, 2, 1)>(vb), l3 = tr_read<v_rd_off(D0, 3, 0)>(vb), h3 = tr_read<v_rd_off(D0, 3, 1)>(vb);
  asm volatile("s_waitcnt lgkmcnt(0)" ::: "memory"); SBAR();
#define PK(L, H) (bf16x8){L[0], L[1], L[2], L[3], H[0], H[1], H[2], H[3]}
  od = __builtin_amdgcn_mfma_f32_32x32x16_bf16(pa0, PK(l0, h0), od, 0, 0, 0);
  od = __builtin_amdgcn_mfma_f32_32x32x16_bf16(pa1, PK(l1, h1), od, 0, 0, 0);
  od = __builtin_amdgcn_mfma_f32_32x32x16_bf16(pa2, PK(l2, h2), od, 0, 0, 0);
  od = __builtin_amdgcn_mfma_f32_32x32x16_bf16(pa3, PK(l3, h3), od, 0, 0, 0);
#undef PK
}
__device__ __forceinline__ void pv_d0(f32x16* o, int vb, bf16x8 pa0, bf16x8 pa1, bf16x8 pa2, bf16x8 pa3) {
  pv_one<0>(o[0], vb, pa0, pa1, pa2, pa3); pv_one<1>(o[1], vb, pa0, pa1, pa2, pa3); pv_one<2>(o[2], vb, pa0, pa1, pa2, pa3); pv_one<3>(o[3], vb, pa0, pa1, pa2, pa3);
}

template <int DK, class F, class BG>
__device__ __forceinline__ void attn_unit(const F& f, char* lds, const int tid_in, BG& bg) {
  constexpr int SHM_V = KVBLK * 128 * 2, SHM_K = KVBLK * (DK * 2 + 16), KP = DK / 64, KPR = DK / 8;
  const int tid = opq_v(tid_in);
  const int wid = tid >> 6, lane = tid & 63, r32 = lane & 31, hi = lane >> 5;
  char* V_lds = lds; char* K_lds = lds + 2 * SHM_V;
  float* ws = (float*)(lds + 2 * SHM_V + 2 * SHM_K) + wid * 64; float* li_l = ws; float* al_l = ws + 32;
  const int myrow = wid * QBLK + r32;
  float m_reg = f.m_init(myrow), l_reg = f.l_init(); f32x16 o[4] = {}; bf16x8 qr[DK / 16];
  const bf16_t* Qw = f.qptr(myrow) + hi * 8;
#pragma unroll
  for (int d0 = 0; d0 < DK / 16; ++d0) qr[d0] = f.loadq(Qw + d0 * 16);
  f.template fixq<DK / 16>(qr, myrow, hi);
  const int wid_u = __builtin_amdgcn_readfirstlane(wid);
  const int sr = tid >> 4, sc = (tid & 15) * 8, vst0 = v_st(sr, sc), vst1 = v_st(32 + sr, sc);
  unsigned kvo[KP]; int kst[KP];
#pragma unroll
  for (int q = 0; q < KP; ++q) { const int p = tid + 512 * q, krw = p / KPR, kcl = (p % KPR) * 8; kvo[q] = (unsigned)(krw * f.ldk + kcl) * 2u; kst[q] = kswz<DK>(krw, kcl * 2); }
  const unsigned vvo0 = (unsigned)(sr * f.ldv + sc) * 2u, vvo1 = vvo0 + (unsigned)(64 * f.ldv);
  const int vb0 = (int)(uintptr_t)V_lds + v_rd_base(lane);
  const float C = f.C, thr_raw = f.thr_raw; const int NT = f.NT;
  bf16x8 vs0, vs1, ks[KP];
#define SLOAD(jt) do { const long _k0 = f.key0(jt); const char* _vb = (const char*)f.Vb + _k0 * (f.ldv * 2); const char* _kb = (const char*)f.Kb + _k0 * (f.ldk * 2); \
    vs0 = *(const bf16x8*)(_vb + vvo0); vs1 = *(const bf16x8*)(_vb + vvo1); \
    _Pragma("unroll") for (int _q = 0; _q < KP; ++_q) ks[_q] = *(const bf16x8*)(_kb + kvo[_q]); } while (0)
#define SWRITE(b) do { *(bf16x8*)(V_lds + (b) * SHM_V + vst0) = vs0; *(bf16x8*)(V_lds + (b) * SHM_V + vst1) = vs1; \
    _Pragma("unroll") for (int _q = 0; _q < KP; ++_q) *(bf16x8*)(K_lds + (b) * SHM_K + kst[_q]) = ks[_q]; } while (0)
  SLOAD(0); SWRITE(0); if (NT > 1) SLOAD(1);
  __syncthreads();
#pragma unroll 1
  for (int j = 0; j < NT; ++j) {
    const int b = j & 1;
    f32x16 p0, p1; bf16x8 pa0, pa1, pa2, pa3; float mn, alpha;
    const bool sk = f.skip(j, wid_u);
    if (!sk) qkt<DK>(p0, p1, K_lds + b * SHM_K, qr, r32, hi);
    if (j + 1 < NT) { SWRITE(b ^ 1); if (j + 2 < NT) SLOAD(j + 2); }
    bg.step_b(lane); bg.step_a(lane);
    if (!sk) {
    f.apply(p0, p1, j, myrow, hi);
    partialSM(p0, p1, m_reg, mn, alpha, C, thr_raw);
    if (__any(alpha < 1.f)) { if (hi == 0) al_l[r32] = alpha; asm volatile("s_waitcnt lgkmcnt(0)" ::: "memory");
#pragma unroll
      for (int d = 0; d < 4; ++d)
#pragma unroll
        for (int r = 0; r < 16; ++r) o[d][r] *= al_l[crow(r, hi)]; }
    finishSM(p0, p1, alpha, l_reg, pa0, pa1, pa2, pa3); SBAR();
    pv_d0(o, vb0 + b * SHM_V, pa0, pa1, pa2, pa3);
    }
    __syncthreads();
  }
  if (hi == 0) li_l[r32] = l_reg; asm volatile("s_waitcnt lgkmcnt(0)" ::: "memory");
  const int orow0 = opq_v(wid * QBLK + 4 * hi);
  float rli[16];
#pragma unroll
  for (int r = 0; r < 16; ++r) rli[r] = __builtin_amdgcn_rcpf(li_l[crow(r, hi)]);
#pragma unroll
  for (int r = 0; r < 16; ++r) { bf16_t* op = f.optr(orow0 + (r & 3) + 8 * (r >> 2)) + r32;
#pragma unroll
    for (int d0 = 0; d0 < 4; ++d0) op[d0 * 32] = f2bf(o[d0][r] * rli[r]); }
#undef SLOAD
#undef SWRITE
}
template <int DK, class F>
__device__ __forceinline__ void attn_unit2(const F& f, char* lds, const int tid) {
  constexpr int SHM_V = KVBLK * 128 * 2, SHM_K = KVBLK * (DK * 2 + 16), KP = DK / 64, KPR = DK / 8;
  const int wid = tid >> 6, lane = tid & 63, r32 = lane & 31, hi = lane >> 5;
  char* V_lds = lds; char* K_lds = lds + 2 * SHM_V;
  float* ws = (float*)(lds + 2 * SHM_V + 2 * SHM_K) + wid * 64; float* li_l = ws; float* al_l = ws + 32;
  const int myrow = wid * QBLK + r32;
  float m_reg = f.m_init(myrow), l_reg = f.l_init(); f32x16 o[4] = {}; bf16x8 qr[DK / 16];
  const bf16_t* Qw = f.qptr(myrow) + hi * 8;
#pragma unroll
  for (int d0 = 0; d0 < DK / 16; ++d0) qr[d0] = *reinterpret_cast<const bf16x8*>(Qw + d0 * 16);
  const int sr = tid >> 4, sc = (tid & 15) * 8, vst0 = v_st(sr, sc), vst1 = v_st(32 + sr, sc);
  unsigned kvo[KP]; int kst[KP];
#pragma unroll
  for (int q = 0; q < KP; ++q) { const int p = tid + 512 * q, krw = p / KPR, kcl = (p % KPR) * 8; kvo[q] = (unsigned)(krw * f.ldk + kcl) * 2u; kst[q] = kswz<DK>(krw, kcl * 2); }
  const unsigned vvo0 = (unsigned)(sr * f.ldv + sc) * 2u, vvo1 = vvo0 + (unsigned)(64 * f.ldv);
  const int vb0 = (int)(uintptr_t)V_lds + v_rd_base(lane);
  const float C = f.C, thr_raw = f.thr_raw; const int NT = f.NT;
  struct { bf16x8 vs0, vs1, ks[KP]; } sr_[1];
#define SLOAD(i, jt) do { const long _k0 = f.key0(jt); const char* _vb = (const char*)f.Vb + _k0 * (f.ldv * 2); const char* _kb = (const char*)f.Kb + _k0 * (f.ldk * 2); \
    sr_[i].vs0 = *(const bf16x8*)(_vb + vvo0); sr_[i].vs1 = *(const bf16x8*)(_vb + vvo1); \
    _Pragma("unroll") for (int _q = 0; _q < KP; ++_q) sr_[i].ks[_q] = *(const bf16x8*)(_kb + kvo[_q]); } while (0)
#define SWRITE(b, i) do { *(bf16x8*)(V_lds + (b) * SHM_V + vst0) = sr_[i].vs0; *(bf16x8*)(V_lds + (b) * SHM_V + vst1) = sr_[i].vs1; \
    _Pragma("unroll") for (int _q = 0; _q < KP; ++_q) *(bf16x8*)(K_lds + (b) * SHM_K + kst[_q]) = sr_[i].ks[_q]; } while (0)
#define SWAIT() asm volatile("s_waitcnt vmcnt(0)" ::: "memory")
#define RESC(a) do { if (__any((a) < 1.f)) { if (hi == 0) al_l[r32] = (a); asm volatile("s_waitcnt lgkmcnt(0)" ::: "memory"); \
    _Pragma("unroll") for (int d = 0; d < 4; ++d) _Pragma("unroll") for (int r = 0; r < 16; ++r) o[d][r] *= al_l[crow(r, hi)]; } } while (0)
#define PSM(P0, P1, MN, AL, jt) do { f.apply(P0, P1, (jt), myrow, hi); partialSM(P0, P1, m_reg, MN, AL, C, thr_raw); } while (0)
  f32x16 pA0, pA1, pB0, pB1; float mnA, mnB, alA, alB; bf16x8 pa0, pa1, pa2, pa3;
  constexpr int SE = 0, SO = 0;
  SLOAD(SE, 0); asm volatile("s_waitcnt vmcnt(0)" ::: "memory"); SWRITE(0, SE); __syncthreads();
  qkt<DK>(pA0, pA1, K_lds, qr, r32, hi); PSM(pA0, pA1, mnA, alA, 0);
  SLOAD(SO, 1);
  SWAIT(); SWRITE(1, SO); __syncthreads();
#pragma unroll 1
  for (int j = 1; j + 1 < NT; j += 2) {
    SBAR(); qkt<DK>(pB0, pB1, K_lds + SHM_K, qr, r32, hi);
    finishSM(pA0, pA1, alA, l_reg, pa0, pa1, pa2, pa3); SBAR();
    SLOAD(SE, j + 1); SBAR();
    pv_d0(o, vb0, pa0, pa1, pa2, pa3); PSM(pB0, pB1, mnB, alB, j);
    __syncthreads(); SWAIT(); SWRITE(0, SE);
    RESC(alB); __syncthreads();
    SBAR(); qkt<DK>(pA0, pA1, K_lds, qr, r32, hi);
    finishSM(pB0, pB1, alB, l_reg, pa0, pa1, pa2, pa3); SBAR();
    SLOAD(SO, j + 2); SBAR();
    pv_d0(o, vb0 + (int)SHM_V, pa0, pa1, pa2, pa3); PSM(pA0, pA1, mnA, alA, j + 1);
    __syncthreads(); SWAIT(); SWRITE(1, SO);
    RESC(alA); __syncthreads();
  }
  SBAR(); qkt<DK>(pB0, pB1, K_lds + SHM_K, qr, r32, hi);
  finishSM(pA0, pA1, alA, l_reg, pa0, pa1, pa2, pa3); SBAR();
  pv_d0(o, vb0, pa0, pa1, pa2, pa3); PSM(pB0, pB1, mnB, alB, NT - 1);
  __syncthreads(); RESC(alB);
  finishSM(pB0, pB1, alB, l_reg, pa0, pa1, pa2, pa3); SBAR();
  pv_d0(o, vb0 + (int)SHM_V, pa0, pa1, pa2, pa3);
  if (hi == 0) li_l[r32] = l_reg; asm volatile("s_waitcnt lgkmcnt(0)" ::: "memory");
  const int orow0 = opq_v(wid * QBLK + 4 * hi);
  float rli[16];
#pragma unroll
  for (int r = 0; r < 16; ++r) rli[r] = __builtin_amdgcn_rcpf(li_l[crow(r, hi)]);
#pragma unroll
  for (int r = 0; r < 16; ++r) { bf16_t* op = f.optr(orow0 + (r & 3) + 8 * (r >> 2)) + r32;
#pragma unroll
    for (int d0 = 0; d0 < 4; ++d0) op[d0 * 32] = f2bf(o[d0][r] * rli[r]); }
#undef SLOAD
#undef SWRITE
#undef SWAIT
#undef RESC
#undef PSM
}
constexpr float LOG2E = 1.4426950408889634f;
constexpr float SC128 = 0.088388347648318440f, ISC128 = 11.313708498984761f;
constexpr float SC192 = 0.072168783648703220f;

struct FBase {
  const bf16_t* Kb; const bf16_t* Vb; int ldk, ldv, NT; float C, thr_raw;
  __device__ __forceinline__ float l_init() const { return 0.f; }
  __device__ __forceinline__ float m_init(int) const { return -1e30f; }
  __device__ __forceinline__ void apply(f32x16&, f32x16&, int, int, int) const {}
  __device__ __forceinline__ bf16x8 loadq(const bf16_t* p) const { return *reinterpret_cast<const bf16x8*>(p); }
  __device__ __forceinline__ bool skip(int, int) const { return false; }
  template <int NQ> __device__ __forceinline__ void fixq(bf16x8 (&)[NQ], int, int) const {}
};
struct FDense : FBase {
  const bf16_t* Q; bf16_t* O; int ldq, ldo; long k0;
  __device__ __forceinline__ const bf16_t* qptr(int row) const { return Q + (size_t)row * ldq; }
  __device__ __forceinline__ bf16_t* optr(int row) const { return O + (size_t)row * ldo; }
  __device__ __forceinline__ long key0(int j) const { return k0 + 64 * j; }
};
struct FCross : FDense {
  size_t slab; const float* ss; int row0g;
  __device__ __forceinline__ bf16x8 loadq(const bf16_t* p) const { return *reinterpret_cast<const bf16x8*>(p); }
  template <int NQ> __device__ __forceinline__ void fixq(bf16x8 (&qr)[NQ], int row, int hi) const {
    const float* sp = ss + (size_t)(row0g + row) * 32; float sq = 0.f;
#pragma unroll
    for (int i = 0; i < 8; ++i) { const f32x4 p = *(const f32x4*)(sp + 4 * i); sq += (p[0] + p[1]) + (p[2] + p[3]); }
    const float rs = 1.0f / sqrtf(sq * (1.0f / DM) + EPS);
    const bf16_t* q1 = Q + (size_t)row * ldq + hi * 8 + slab;
#pragma unroll
    for (int d = 0; d < NQ; ++d) { float a[8];
      { const u32x4 w = *reinterpret_cast<const u32x4*>(&qr[d]); a[0] = bf2f(w.x & 0xffffu); a[1] = bf2f(w.x >> 16); a[2] = bf2f(w.y & 0xffffu); a[3] = bf2f(w.y >> 16); a[4] = bf2f(w.z & 0xffffu); a[5] = bf2f(w.z >> 16); a[6] = bf2f(w.w & 0xffffu); a[7] = bf2f(w.w >> 16); }
#pragma unroll
      for (int k = 0; k < 3; ++k) { const u32x4 w = *(const u32x4*)(q1 + k * slab + d * 16);
        a[0] += bf2f(w.x & 0xffffu); a[1] += bf2f(w.x >> 16); a[2] += bf2f(w.y & 0xffffu); a[3] += bf2f(w.y >> 16); a[4] += bf2f(w.z & 0xffffu); a[5] += bf2f(w.z >> 16); a[6] += bf2f(w.w & 0xffffu); a[7] += bf2f(w.w >> 16); }
      u32x4 o = {cvtpk(a[0] * rs, a[1] * rs), cvtpk(a[2] * rs, a[3] * rs), cvtpk(a[4] * rs, a[5] * rs), cvtpk(a[6] * rs, a[7] * rs)}; qr[d] = *reinterpret_cast<bf16x8*>(&o); }
  }
};
struct FMla : FDense {
  const float* tab; int pos0;
  template <int NQ> __device__ __forceinline__ void fixq(bf16x8 (&qr)[NQ], int row, int hi) const {
#pragma unroll
    for (int d = 8; d < 10; ++d) { const float* cs = tab + 2 * ((size_t)(pos0 + row) * 32 + (d - 8) * 16 + hi * 8);
      const f32x4 c0 = *(const f32x4*)cs, c1 = *(const f32x4*)(cs + 4), c2 = *(const f32x4*)(cs + 8), c3 = *(const f32x4*)(cs + 12);
      const float co[8] = {c0[0], c0[2], c1[0], c1[2], c2[0], c2[2], c3[0], c3[2]}, si[8] = {c0[1], c0[3], c1[1], c1[3], c2[1], c2[3], c3[1], c3[3]};
      float y1[8], y2[8];
#pragma unroll
      for (int e = 0; e < 8; ++e) { const float x1 = bf2f((unsigned)(unsigned short)qr[d][e]), x2 = bf2f((unsigned)(unsigned short)qr[d + 2][e]); y1[e] = x1 * co[e] - x2 * si[e]; y2[e] = x2 * co[e] + x1 * si[e]; }
      u32x4 w1 = {cvtpk(y1[0], y1[1]), cvtpk(y1[2], y1[3]), cvtpk(y1[4], y1[5]), cvtpk(y1[6], y1[7])}, w2 = {cvtpk(y2[0], y2[1]), cvtpk(y2[2], y2[3]), cvtpk(y2[4], y2[5]), cvtpk(y2[6], y2[7])};
      qr[d] = *reinterpret_cast<bf16x8*>(&w1); qr[d + 2] = *reinterpret_cast<bf16x8*>(&w2); }
  }
};
struct FWin : FDense {
  int qpos0, kpos0; float sink_raw;
  __device__ __forceinline__ float l_init() const { return 1.f; }
  __device__ __forceinline__ float m_init(int) const { return sink_raw; }
  __device__ __forceinline__ bool skip(int j, int wid) const { const int kmin = kpos0 + 64 * j, qmin = qpos0 + 32 * wid; return kmin > qmin + 31 + 128 || kmin + 63 < qmin - 128; }
  __device__ __forceinline__ void apply(f32x16& p0, f32x16& p1, int j, int row, int hi) const {
    const int d0 = kpos0 + 64 * j - (qpos0 + row);
    const float ninf = -__builtin_inff();
#pragma unroll
    for (int r = 0; r < 16; ++r) { const int d = d0 + crow(r, hi);
      p0[r] = (d >= -128 && d <= 128) ? p0[r] : ninf; p1[r] = (d + 32 >= -128 && d + 32 <= 128) ? p1[r] : ninf; }
  }
};
struct FNat : FBase {
  const bf16_t* Q; bf16_t* O; long tok0; int kvh, rq, rb; const float* bias;
  __device__ __forceinline__ const bf16_t* qptr(int row) const { return Q + (size_t)(tok0 + (row & 63)) * GQA_IN + (kvh * 4 + (row >> 6)) * HD; }
  __device__ __forceinline__ bf16_t* optr(int row) const { return O + (size_t)(tok0 + (row & 63)) * DM + (kvh * 4 + (row >> 6)) * HD; }
  __device__ __forceinline__ long key0(int j) const { return tok0 + (long)(rb + j - rq) * 64; }
  __device__ __forceinline__ void apply(f32x16& p0, f32x16& p1, int j, int row, int hi) const {
    const int g = row >> 6, qc = row & 63; int cs = qc - 8; cs = cs < 0 ? 0 : (cs > 48 ? 48 : cs);
    const int dr = rb + j - rq + 7;
    const float* bt = bias + g * 465 + dr * 31 + 15 - qc;
    const float ninf = -__builtin_inff();
#pragma unroll
    for (int r = 0; r < 16; ++r) { const int kc = crow(r, hi);
      { const bool ok = (kc >= cs) && (kc < cs + 16); const float bv = ok ? bt[kc] : 0.f; p0[r] = ok ? p0[r] + bv : ninf; }
      { const int k2 = kc + 32; const bool ok = (k2 >= cs) && (k2 < cs + 16); const float bv = ok ? bt[k2] : 0.f; p1[r] = ok ? p1[r] + bv : ninf; } }
  }
};
}

__device__ __forceinline__ void row_load(const float* p, int lane, f32x4 (&v)[8]) {
#pragma unroll
    for (int j = 0; j < 8; ++j) v[j] = *(const f32x4*)(p + 4 * lane + 256 * j);
}
__device__ __forceinline__ float row_rstd(const f32x4 (&v)[8]) {
    float s = 0.f;
#pragma unroll
    for (int j = 0; j < 8; ++j) s += (v[j].x * v[j].x + v[j].y * v[j].y) + (v[j].z * v[j].z + v[j].w * v[j].w);
    return 1.0f / sqrtf(wave_sum(s) * (1.0f / DM) + EPS);
}
__device__ __forceinline__ void row_store_norm_bf16(bf16_t* o, const float* g, int lane, const f32x4 (&v)[8], float rstd) {
#pragma unroll
    for (int j = 0; j < 8; ++j) { const f32x4 gg = *(const f32x4*)(g + 4 * lane + 256 * j);
        u32x2 w; w.x = cvtpk(v[j].x * rstd * gg.x, v[j].y * rstd * gg.y); w.y = cvtpk(v[j].z * rstd * gg.z, v[j].w * rstd * gg.w);
        *(u32x2*)(o + 4 * lane + 256 * j) = w; }
}
__device__ __forceinline__ void rowb_load(const bf16_t* p, int lane, f32x4 (&v)[8]) {
#pragma unroll
    for (int j = 0; j < 8; ++j) { const u32x2 w = *(const u32x2*)(p + 4 * lane + 256 * j); v[j] = (f32x4){bf2f(w.x & 0xffffu), bf2f(w.x >> 16), bf2f(w.y & 0xffffu), bf2f(w.y >> 16)}; }
}
__device__ __forceinline__ void rowb_store(bf16_t* p, int lane, const f32x4 (&v)[8]) {
#pragma unroll
    for (int j = 0; j < 8; ++j) { u32x2 w; w.x = cvtpk(v[j].x, v[j].y); w.y = cvtpk(v[j].z, v[j].w); *(u32x2*)(p + 4 * lane + 256 * j) = w; }
}
__device__ __forceinline__ void row_add_y(f32x4 (&v)[8], const u32x2 (&w)[8]) {
#pragma unroll
    for (int j = 0; j < 8; ++j) { v[j].x += bf2f(w[j].x & 0xffffu); v[j].y += bf2f(w[j].x >> 16); v[j].z += bf2f(w[j].y & 0xffffu); v[j].w += bf2f(w[j].y >> 16); }
}
__device__ __forceinline__ void row_combine(f32x4 (&v)[8], const int* slot_row, const bf16_t* Y, int b, int lane) {
    const int myslot = lane < NE ? slot_row[lane] : -1;
    unsigned long long m = __ballot(myslot >= 0);
#pragma unroll 1
    while (m) {
        const int e0 = __builtin_ctzll(m); m &= m - 1; const bool two = m != 0; const int e1 = two ? __builtin_ctzll(m) : e0; if (two) m &= m - 1;
        const int s0 = __builtin_amdgcn_readlane(myslot, e0), s1 = __builtin_amdgcn_readlane(myslot, e1);
        const bf16_t* y0 = Y + ((size_t)(b * NE + e0) * CAP + s0) * DM; const bf16_t* y1 = Y + ((size_t)(b * NE + e1) * CAP + s1) * DM;
        u32x2 w0[8], w1[8];
#pragma unroll
        for (int j = 0; j < 8; ++j) { w0[j] = *(const u32x2*)(y0 + 4 * lane + 256 * j); w1[j] = *(const u32x2*)(y1 + 4 * lane + 256 * j); }
        row_add_y(v, w0); if (two) row_add_y(v, w1);
    }
}
struct RowPre { u32x2 w[8]; int slot; };
__device__ __forceinline__ void rowpre_load(RowPre& p, const bf16_t* hrow, const int* slot_row, int lane) {
#pragma unroll
    for (int j = 0; j < 8; ++j) p.w[j] = *(const u32x2*)(hrow + 4 * lane + 256 * j);
    p.slot = lane < NE ? slot_row[lane] : -1;
}
__device__ __forceinline__ void rowpre_unpack(const RowPre& p, f32x4 (&v)[8]) {
#pragma unroll
    for (int j = 0; j < 8; ++j) v[j] = (f32x4){bf2f(p.w[j].x & 0xffffu), bf2f(p.w[j].x >> 16), bf2f(p.w[j].y & 0xffffu), bf2f(p.w[j].y >> 16)};
}
__device__ __forceinline__ void row_combine_s(f32x4 (&v)[8], int myslot, const bf16_t* Y, int b, int lane) {
    unsigned long long m = __ballot(myslot >= 0);
#pragma unroll 1
    while (m) {
        const int e0 = __builtin_ctzll(m); m &= m - 1; const bool two = m != 0; const int e1 = two ? __builtin_ctzll(m) : e0; if (two) m &= m - 1;
        const int s0 = __builtin_amdgcn_readlane(myslot, e0), s1 = __builtin_amdgcn_readlane(myslot, e1);
        const bf16_t* y0 = Y + ((size_t)(b * NE + e0) * CAP + s0) * DM; const bf16_t* y1 = Y + ((size_t)(b * NE + e1) * CAP + s1) * DM;
        u32x2 w0[8], w1[8];
#pragma unroll
        for (int j = 0; j < 8; ++j) { w0[j] = *(const u32x2*)(y0 + 4 * lane + 256 * j); w1[j] = *(const u32x2*)(y1 + 4 * lane + 256 * j); }
        row_add_y(v, w0); if (two) row_add_y(v, w1);
    }
}
__device__ __forceinline__ void transpose_item(const float* W, int N, bf16_t* WT, int ldk, int k0, int n0, int drow0, LAS float* scr, int lane, const float* gk) {
    const int krow = lane >> 3, n4 = lane & 7;
    const float* p0 = W + (size_t)(k0 + krow) * N + n0 + 4 * n4; const size_t st = (size_t)8 * N;
    f32x4 r[8];
#pragma unroll
    for (int i = 0; i < 8; ++i) r[i] = __builtin_nontemporal_load((const f32x4*)(p0 + i * st));
#pragma unroll
    for (int i = 0; i < 8; ++i) { LAS float* q = scr + (8 * i + krow) * 33 + 4 * n4; q[0] = r[i].x; q[1] = r[i].y; q[2] = r[i].z; q[3] = r[i].w; }
    const int c = lane & 7;
    f32x4 g0 = {1.f, 1.f, 1.f, 1.f}, g1 = {1.f, 1.f, 1.f, 1.f}; if (gk) { g0 = *(const f32x4*)(gk + k0 + 8 * c); g1 = *(const f32x4*)(gk + k0 + 8 * c + 4); }
    asm volatile("s_waitcnt lgkmcnt(0)" ::: "memory");
#pragma unroll
    for (int j = 0; j < 4; ++j) { const int n = (lane >> 3) + 8 * j; const LAS float* s = scr + (8 * c) * 33 + n;
        u32x4 o; o.x = cvtpk(s[0 * 33] * g0[0], s[1 * 33] * g0[1]); o.y = cvtpk(s[2 * 33] * g0[2], s[3 * 33] * g0[3]); o.z = cvtpk(s[4 * 33] * g1[0], s[5 * 33] * g1[1]); o.w = cvtpk(s[6 * 33] * g1[2], s[7 * 33] * g1[3]);
        __builtin_nontemporal_store(o, (u32x4*)(WT + (size_t)(drow0 + n) * ldk + k0 + 8 * c)); }
    asm volatile("s_waitcnt lgkmcnt(0)" ::: "memory");
}

__device__ __forceinline__ void bg_drain(bgw::Work& w, int lane) {
    w.half = 0; w.pending = 0;
#pragma unroll 1
    for (; w.cur < w.end; ++w.cur) { const bgw::Item t = w.decode(w.cur); transpose_item(t.src, t.N, t.dst, t.K, t.k0, t.n0, t.drow0, w.scr, lane, t.gk); }
}

struct Args { const float* in[30]; float* out; unsigned char* ws; int ph_lo, ph_hi, flags, pad; };
static_assert(true, "");
enum { IN_X = 0, IN_MEM, IN_GMIX, IN_GXA, IN_GFFN, IN_A_WIN, IN_A_SINK, IN_A_WOUT, IN_B_WIN, IN_B_QG, IN_B_KG, IN_B_WOUT, IN_C_WIN, IN_C_QLG, IN_C_KVLG, IN_C_WUQ, IN_C_WUKV, IN_C_WOUT,
       IN_D_WIN, IN_D_RPB, IN_D_WOUT, IN_MEMG, IN_XA_WQ, IN_XA_WKV, IN_XA_WO, IN_ROUTER, IN_M_GATE, IN_M_UP, IN_M_DOWN, IN_FINALG };
constexpr int PH_PER_LAYER = 15, PH_FINAL = 1 + 4 * PH_PER_LAYER, N_PHASES = PH_FINAL + 1;

__global__ void __launch_bounds__(512, 2) fwd(Args args) {
    extern __shared__ __attribute__((aligned(16))) unsigned char lds[];
    LAS unsigned char* ldsl = (LAS unsigned char*)lds;
    const int wave0 = __builtin_amdgcn_readfirstlane(threadIdx.x >> 6), G0 = gridDim.x, bx0 = blockIdx.x;
#define TID0 (opq_s(wave0) * 64 + (int)__builtin_amdgcn_mbcnt_hi(~0u, __builtin_amdgcn_mbcnt_lo(~0u, (unsigned)opq_s(0))))
    const int tid0 = TID0;
    for (int u = tid0; u < (LDS_BYTES - LDSCTL_OFF) / 4; u += 512) ((LAS unsigned*)(ldsl + LDSCTL_OFF))[u] = 0u;
    __syncthreads();
    volatile LAS unsigned long long* ptab = (volatile LAS unsigned long long*)(ldsl + LDSCTL_OFF + 256);
    if (tid0 < 30) ptab[tid0] = (unsigned long long)args.in[tid0];
    __syncthreads();
    XcdBarrier bar = xcd_barrier_post((unsigned*)(args.ws + WS_CTL) + 1024, (volatile LAS unsigned*)(ldsl + LDSCTL_OFF + 64), tid0);
    const int lo = args.ph_lo, hi = args.ph_hi;
#define IN(k) (lo <= (k) && (k) < hi)
#define SEAM(k) do { if (IN(k) && (k) + 1 < hi) xcd_barrier(bar, TID0); } while (0)

#define WSP unsigned char* ws = opaque(args.ws); const int tid = opq_v(TID0), lane = tid & 63, wave = __builtin_amdgcn_readfirstlane(tid >> 6); \
    const int G = opq_s(G0), bx = opq_s(bx0), vcu = (G % 8 == 0) ? (bx % 8) * (G / 8) + bx / 8 : bx, gw = vcu * 8 + wave, NGW = G * 8; (void)lane; (void)gw; (void)NGW; (void)vcu
#define XIN (ldp(ptab, IN_X))
#define H ((float*)(ws + A_H))
#define XN ((bf16_t*)(ws + A_XN))
#define QKV ((bf16_t*)(ws + A_QKV))
#define KM ((bf16_t*)(ws + A_KM))
#define VM ((bf16_t*)(ws + A_VM))
#define LAT ((float*)(ws + A_LAT))
#define CN ((bf16_t*)(ws + A_CN))
#define OB ((bf16_t*)(ws + A_O))
#define QX ((bf16_t*)(ws + A_QX))
#define OX ((bf16_t*)(ws + A_OX))
#define KVX ((bf16_t*)(ws + A_KVX))
#define MEMN ((bf16_t*)(ws + A_MEMN))
#define XG ((bf16_t*)(ws + A_XG))
#define HMID ((bf16_t*)(ws + A_HMID))
#define YB ((bf16_t*)(ws + A_Y))
#define AFF ((float*)(ws + WS_AFF))
#define IDX ((int*)(ws + WS_IDX))
#define GATE ((float*)(ws + WS_GATE))
#define SLOT ((int*)(ws + WS_SLOT))
#define TABA ((float*)(ws + WS_TABA))
#define TABBR ((float*)(ws + WS_TABBR))
#define TABBC ((float*)(ws + WS_TABBC))
#define TABC ((float*)(ws + WS_TABC))
#define SS2 ((float*)(ws + WS_SS2))
#define RS1 ((float*)(ws + WS_RS1))
#define RS3 ((float*)(ws + WS_RS3))
#define RSG ((float*)(ws + WS_RSG))
#define HB ((bf16_t*)(ws + A_H))

    if (EN(15) && IN(0)) for (int rep_ = 0, L_ = 0; rep_ < REPS(15); ++rep_) { WSP;
        LAS float* scr = (LAS float*)(ldsl + wave * 16384);
        long base = 0;
#pragma unroll 1
        for (int f = 0; f < (BG_CONVERT ? 13 : (SIDE_DOWN ? 15 : 16)); ++f) {
            const float* src; bf16_t* dst; int nmat, K, N, mode = 0; size_t dstride = 0; const float* gsrc = nullptr; int gdiv = 1;
            switch (f) {
                case 0:  src = ldp(ptab, IN_A_WIN);  dst = (bf16_t*)(ws + W_A_IN);  nmat = 1; K = 2048; N = 3072; gsrc = ldp(ptab, IN_GMIX) + 0 * DM; break;
                case 1:  src = ldp(ptab, IN_A_WOUT); dst = (bf16_t*)(ws + W_A_OUT); nmat = 1; K = 2048; N = 2048; break;
                case 2:  src = ldp(ptab, IN_B_WIN);  dst = (bf16_t*)(ws + W_B_IN);  nmat = 1; K = 2048; N = 3072; gsrc = ldp(ptab, IN_GMIX) + 1 * DM; break;
                case 3:  src = ldp(ptab, IN_B_WOUT); dst = (bf16_t*)(ws + W_B_OUT); nmat = 1; K = 2048; N = 2048; break;
                case 4:  src = ldp(ptab, IN_D_WIN);  dst = (bf16_t*)(ws + W_D_IN);  nmat = 1; K = 2048; N = 3072; gsrc = ldp(ptab, IN_GMIX) + 3 * DM; break;
                case 5:  src = ldp(ptab, IN_D_WOUT); dst = (bf16_t*)(ws + W_D_OUT); nmat = 1; K = 2048; N = 2048; break;
                case 6:  src = ldp(ptab, IN_C_WIN);  dst = (bf16_t*)(ws + W_C_IN);  nmat = 1; K = 2048; N = MLA_IN; gsrc = ldp(ptab, IN_GMIX) + 2 * DM; break;
                case 7:  src = ldp(ptab, IN_C_WUQ);  dst = (bf16_t*)(ws + W_C_UQ);  nmat = 1; K = 512;  N = 3072; break;
                case 8:  src = ldp(ptab, IN_C_WUKV); dst = (bf16_t*)(ws + W_C_UKV); nmat = 1; K = 512;  N = 4096; break;
                case 9:  src = ldp(ptab, IN_C_WOUT); dst = (bf16_t*)(ws + W_C_OUT); nmat = 1; K = 2048; N = 2048; break;
                case 10: src = ldp(ptab, IN_XA_WQ);  dst = (bf16_t*)(ws + W_XQ);    nmat = 4; K = 2048; N = 512;  dstride = (size_t)512 * 2048; gsrc = ldp(ptab, IN_GXA); break;
                case 11: src = ldp(ptab, IN_XA_WKV); dst = (bf16_t*)(ws + W_XKV);   nmat = 4; K = 2048; N = 1024; dstride = (size_t)1024 * 2048; break;
                case 12: src = ldp(ptab, IN_XA_WO);  dst = (bf16_t*)(ws + W_XO);    nmat = 4; K = 512;  N = 2048; dstride = (size_t)2048 * 512; break;
                case 13: src = ldp(ptab, IN_M_GATE); dst = (bf16_t*)(ws + W_M1);    nmat = PIGGY ? 48 : 64; K = 2048; N = 1024; dstride = (size_t)2048 * 2048; mode = 1; gsrc = ldp(ptab, IN_GFFN); gdiv = 16; break;
                case 14: src = ldp(ptab, IN_M_UP);   dst = (bf16_t*)(ws + W_M1);    nmat = PIGGY ? 48 : 64; K = 2048; N = 1024; dstride = (size_t)2048 * 2048; mode = 2; gsrc = ldp(ptab, IN_GFFN); gdiv = 16; break;
                default: src = ldp(ptab, IN_M_DOWN); dst = (bf16_t*)(ws + W_M2);    nmat = PIGGY ? (SIDE_K1 && G == 256 ? 20 : 32) : 64; K = 1024; N = 2048; dstride = (size_t)2048 * 1024; break;
            }
            const int nblk = N / 32, per = (K / 64) * nblk; const long total = (long)nmat * per;
            long it = ((long)gw - (base % NGW) + NGW) % NGW;
#pragma unroll 1
            for (; it < total; it += NGW) {
                int mat = (int)(it / per); const int r = (int)(it % per), kb = r / nblk, nb = r % nblk, n0 = 32 * nb;
                if (PIGGY && f >= 13 && mat >= 16) mat += (f == 15 ? (SIDE_K1 && G == 256 ? 44 : 32) : 16);
                if (SIDE_X && f == 13 && (mat & 15) < 8) continue;
                const int drow0 = mode == 0 ? n0 : ((n0 >> 7) * 256 + (n0 & 127) + (mode == 2 ? 128 : 0));
                transpose_item(src + (size_t)mat * K * N, N, dst + (size_t)mat * dstride, K, 64 * kb, n0, drow0, scr, lane, gsrc ? gsrc + (size_t)(mat / gdiv) * K : nullptr);
            }
            base += total;
        }
        {
            u32x4* z = (u32x4*)((bf16_t*)(ws + W_C_IN) + (size_t)MLA_IN * 2048); const int nz = (MLA_INP - MLA_IN) * 2048 / 8;
            for (int i = gw * 64 + lane; i < nz; i += NGW * 64) z[i] = (u32x4){0u, 0u, 0u, 0u};
        }
        for (int m = gw; m < NB * MEMT + T; m += NGW) {
            f32x4 v[8];
            if (m < NB * MEMT) { row_load(ldp(ptab, IN_MEM) + (size_t)m * DM, lane, v); const float rstd = row_rstd(v); row_store_norm_bf16(MEMN + (size_t)m * DM, ldp(ptab, IN_MEMG), lane, v, rstd); }
            else { const int t = m - NB * MEMT; row_load(XIN + (size_t)t * DM, lane, v); const float rstd = row_rstd(v); rowb_store(HB + (size_t)t * DM, lane, v); if (lane == 0) RS1[t] = rstd; }
        }
        for (int i = gw * 64 + lane; i < 2048 * 16 + 32 * 32 + 64 * 32 + 2048 * 32; i += NGW * 64) {
            int j = i; float* dst; float pos, fr;
            if (j < 2048 * 16) { pos = (float)(j >> 4); fr = exp2f(-(float)(2 * (j & 15)) / 32.0f * 18.931568569324174f); dst = TABA + 2 * j; }
            else { j -= 2048 * 16;
                if (j < 32 * 32) { pos = (float)(j >> 5); fr = exp2f(-(float)(2 * (j & 31)) / 64.0f * 13.287712379549449f); dst = TABBR + 2 * j; }
                else { j -= 32 * 32;
                    if (j < 64 * 32) { pos = (float)(j >> 5); fr = exp2f(-(float)(2 * (j & 31)) / 64.0f * 13.287712379549449f); dst = TABBC + 2 * j; }
                    else { j -= 64 * 32; pos = (float)(j >> 5); fr = exp2f(-(float)(2 * (j & 31)) / 64.0f * 18.931568569324174f); dst = TABC + 2 * j; } } }
            const float ang = pos * fr; dst[0] = cosf(ang); dst[1] = sinf(ang);
        }
        for (int i = gw * 64 + lane; i < 4 * 4096; i += NGW * 64) {
            const int Lr = i >> 12, kk = (i >> 6) & 63, l = i & 63, d0 = kk * 32 + (l >> 4) * 8;
            const float* wsrc = ldp(ptab, IN_ROUTER) + ((size_t)Lr * DM + d0) * NE + (l & 15); const float* gs = ldp(ptab, IN_GFFN) + Lr * DM + d0;
            u32x4 hi4, lo4;
#pragma unroll
            for (int j = 0; j < 4; ++j) { const float w0 = wsrc[(2 * j) * NE] * gs[2 * j], w1 = wsrc[(2 * j + 1) * NE] * gs[2 * j + 1];
                const unsigned hp = cvtpk(w0, w1); hi4[j] = hp; lo4[j] = cvtpk(w0 - __uint_as_float(hp << 16), w1 - __uint_as_float(hp & 0xffff0000u)); }
            u32x4* rw = (u32x4*)(ws + WS_RW) + (size_t)Lr * 8192 + (i & 4095); rw[0] = hi4; rw[4096] = lo4;
        }
    }
    SEAM(0);

#pragma unroll 1
    for (int L = 0; L < 4; ++L) {
        const int P = 1 + L * PH_PER_LAYER; const int L_ = L; (void)L_;
        if (EN(0) && L > 0 && IN(P + 0)) for (int rep_ = 0; rep_ < REPS(0); ++rep_) { WSP;
            bf16_t* hout = (bf16_t*)(ws + A_H + (size_t)(args.flags & 1) * (A_TRASH - A_H));
            RowPre cur; if (gw < T) rowpre_load(cur, HB + (size_t)gw * DM, SLOT + (size_t)gw * NE, lane);
#pragma unroll 1
            for (int t = gw; t < T; t += NGW) {
                RowPre nx = cur; const int tn = t + NGW; if (tn < T) rowpre_load(nx, HB + (size_t)tn * DM, SLOT + (size_t)tn * NE, lane);
                f32x4 v[8]; rowpre_unpack(cur, v);
                row_combine_s(v, cur.slot, YB, t / SEQ, lane);
                rowb_store(hout + (size_t)t * DM, lane, v);
                const float rstd = row_rstd(v); if (lane == 0) RS1[t] = rstd;
                cur = nx;
            }
        }
        if (L > 0) SEAM(P + 0);
        if (EN(1) && IN(P + 1)) for (int rep_ = 0; rep_ < REPS(1); ++rep_) { WSP;
            if (L == 2) {
                pg8::PlainOrder S; S.init(HB, ws + W_C_IN, DM, DM, T, MLA_INP, G, bx);
                pg8::EpiF32RS1 E{LAT, MLA_INP, RS1};
                pg8::gemm_phase<pg8::EpiF32RS1, pg8::PlainOrder>(ldsl, tid, DM, DM, DM, S, E);
            } else {
                const size_t wo = L == 0 ? W_A_IN : (L == 1 ? W_B_IN : W_D_IN);
                pg8::PlainOrder S; S.init(HB, ws + wo, DM, DM, T, GQA_IN, G, bx);
                pg8::EpiBf16RS1 E{QKV, GQA_IN, RS1};
                pg8::gemm_phase<pg8::EpiBf16RS1, pg8::PlainOrder>(ldsl, tid, DM, DM, DM, S, E);
                if (SIDE_K1 && PIGGY && rep_ == 0 && G == 256 && bx >= (L == 0 ? 192 : 128)) {
                    const int nw = (L == 0 ? 64 : 128) * 8, w0 = (bx - (L == 0 ? 192 : 128)) * 8 + wave, nit = (L == 0 ? 4 : 8) * 1024, mat0 = L == 1 ? 32 : (L == 3 ? 48 : 56);
                    LAS float* scr = (LAS float*)(ldsl + wave * 16384); const float* wd = ldp(ptab, IN_M_DOWN);
#pragma unroll 1
                    for (int it = w0; it < nit; it += nw) { const int mat = mat0 + (it >> 10), r = it & 1023, kb = r >> 6, n0 = (r & 63) * 32;
                        transpose_item(wd + (size_t)mat * 1024 * 2048, 2048, (bf16_t*)(ws + W_M2) + (size_t)mat * 2048 * 1024, 1024, 64 * kb, n0, n0, scr, lane, nullptr); }
                }
                if (L == 0) {
#pragma unroll 1
                    for (int l = 0; l < 4; ++l) {
                        pg8::PlainOrder S2; S2.init(MEMN, ws + W_XKV + (size_t)l * 1024 * 2048 * 2, DM, DM, NB * MEMT, 1024, G, (bx + 2 * G - G / 2 - 16 * l) % G);
                        pg8::EpiBf16 E2{KVX + (size_t)l * 1024 * 1024, 1024};
                        pg8::gemm_phase<pg8::EpiBf16, pg8::PlainOrder>(ldsl, tid, DM, DM, DM, S2, E2);
                    }
                }
            }
        }
        SEAM(P + 1);
        if (EN(2) && L != 3 && IN(P + 2)) for (int rep_ = 0; rep_ < REPS(2); ++rep_) { WSP;
            if (L == 0) {
                for (int i = gw * 64 + lane; i < T * 20; i += NGW * 64) {
                    const int tk = i / 20, hd = i % 20;
                    u32x4* p = (u32x4*)(QKV + (size_t)tk * GQA_IN + hd * HD); const f32x4* cs = (const f32x4*)(TABA + 2 * ((tk % SEQ) * 16));
                    const u32x4 a0 = p[0], a1 = p[1], b0 = p[2], b1 = p[3];
                    f32x4 t[8];
#pragma unroll
                    for (int q = 0; q < 8; ++q) t[q] = cs[q];
                    const unsigned xa[8] = {a0.x, a0.y, a0.z, a0.w, a1.x, a1.y, a1.z, a1.w}, xb[8] = {b0.x, b0.y, b0.z, b0.w, b1.x, b1.y, b1.z, b1.w};
                    unsigned oa[8], ob[8];
#pragma unroll
                    for (int q = 0; q < 8; ++q) { const float x1l = bf2f(xa[q] & 0xffffu), x1h = bf2f(xa[q] >> 16), x2l = bf2f(xb[q] & 0xffffu), x2h = bf2f(xb[q] >> 16);
                        oa[q] = cvtpk(x1l * t[q][0] - x2l * t[q][1], x1h * t[q][2] - x2h * t[q][3]); ob[q] = cvtpk(x2l * t[q][0] + x1l * t[q][1], x2h * t[q][2] + x1h * t[q][3]); }
                    p[0] = (u32x4){oa[0], oa[1], oa[2], oa[3]}; p[1] = (u32x4){oa[4], oa[5], oa[6], oa[7]}; p[2] = (u32x4){ob[0], ob[1], ob[2], ob[3]}; p[3] = (u32x4){ob[4], ob[5], ob[6], ob[7]};
                }
            } else if (L == 1) {
                const float* qg = ldp(ptab, IN_B_QG); const float* kg = ldp(ptab, IN_B_KG);
                const int l16 = lane & 15, sub = lane >> 4;
#pragma unroll 1
                for (int i0 = gw; i0 < T * 5; i0 += 2 * NGW) {
                    u32x4 xin[2]; u32x4* pp[2]; int spos[2]; bool isq[2], ok[2];
#pragma unroll
                    for (int u = 0; u < 2; ++u) { const int i = i0 + u * NGW; ok[u] = i < T * 5; const int ii = ok[u] ? i : i0; const int tk = ii / 5, hd = (ii % 5) * 4 + sub; spos[u] = tk % SEQ; isq[u] = hd < NH;
                        pp[u] = (u32x4*)(QKV + (size_t)tk * GQA_IN + hd * HD + 8 * l16); xin[u] = *pp[u]; }
#pragma unroll
                    for (int u = 0; u < 2; ++u) {
                        const unsigned xw[4] = {xin[u].x, xin[u].y, xin[u].z, xin[u].w}; float a[8]; float ss = 0.f;
#pragma unroll
                        for (int q = 0; q < 4; ++q) { a[2 * q] = bf2f(xw[q] & 0xffffu); a[2 * q + 1] = bf2f(xw[q] >> 16); ss += a[2 * q] * a[2 * q] + a[2 * q + 1] * a[2 * q + 1]; }
                        ss += __shfl_xor(ss, 1); ss += __shfl_xor(ss, 2); ss += __shfl_xor(ss, 4); ss += __shfl_xor(ss, 8);
                        const float rstd = 1.0f / sqrtf(ss * (1.0f / HD) + EPS);
                        const float* g = (isq[u] ? qg : kg) + 8 * l16; const f32x4 g0 = *(const f32x4*)g, g1 = *(const f32x4*)(g + 4);
                        const float gg[8] = {g0[0], g0[1], g0[2], g0[3], g1[0], g1[1], g1[2], g1[3]};
                        const float* cs = (l16 < 8 ? TABBR + 2 * ((spos[u] >> 6) * 32 + 8 * (l16 & 3)) : TABBC + 2 * ((spos[u] & 63) * 32 + 8 * (l16 & 3)));
                        const f32x4 c0 = *(const f32x4*)cs, c1 = *(const f32x4*)(cs + 4), c2 = *(const f32x4*)(cs + 8), c3 = *(const f32x4*)(cs + 12);
                        const float co[8] = {c0[0], c0[2], c1[0], c1[2], c2[0], c2[2], c3[0], c3[2]}, si[8] = {c0[1], c0[3], c1[1], c1[3], c2[1], c2[3], c3[1], c3[3]};
                        const float sg = (l16 & 4) ? 1.f : -1.f; float o[8];
#pragma unroll
                        for (int e = 0; e < 8; ++e) { a[e] = a[e] * rstd * gg[e]; const float pb = __shfl_xor(a[e], 4); o[e] = a[e] * co[e] + sg * pb * si[e]; }
                        if (ok[u]) *pp[u] = (u32x4){cvtpk(o[0], o[1]), cvtpk(o[2], o[3]), cvtpk(o[4], o[5]), cvtpk(o[6], o[7])};
                    }
                }
            } else {
                for (int tk = gw; tk < T; tk += NGW) {
                    const float* lr = LAT + (size_t)tk * MLA_INP;
#pragma unroll
                    for (int part = 0; part < 2; ++part) {
                        const f32x4 u0 = *(const f32x4*)(lr + part * 512 + 8 * lane), u1 = *(const f32x4*)(lr + part * 512 + 8 * lane + 4);
                        const float ss = (u0.x * u0.x + u0.y * u0.y) + (u0.z * u0.z + u0.w * u0.w) + (u1.x * u1.x + u1.y * u1.y) + (u1.z * u1.z + u1.w * u1.w);
                        const float rstd = 1.0f / sqrtf(wave_sum(ss) * (1.0f / 512.0f) + EPS);
                        const float* g = (part == 0 ? ldp(ptab, IN_C_QLG) : ldp(ptab, IN_C_KVLG)) + 8 * lane;
                        const f32x4 g0 = *(const f32x4*)g, g1 = *(const f32x4*)(g + 4);
                        u32x4 w; w.x = cvtpk(u0.x * rstd * g0.x, u0.y * rstd * g0.y); w.y = cvtpk(u0.z * rstd * g0.z, u0.w * rstd * g0.w);
                        w.z = cvtpk(u1.x * rstd * g1.x, u1.y * rstd * g1.y); w.w = cvtpk(u1.z * rstd * g1.z, u1.w * rstd * g1.w);
                        *(u32x4*)(CN + (size_t)tk * 1024 + part * 512 + 8 * lane) = w;
                    }
                    const float a = lr[1024 + lane], b = __shfl_xor(a, 32);
                    const float* cs = TABC + 2 * ((tk % SEQ) * 32 + (lane & 31));
                    const bf16_t o = f2bf(lane < 32 ? a * cs[0] - b * cs[1] : a * cs[0] + b * cs[1]);
                    bf16_t* kp = KM + (size_t)tk * 3072 + 128 + lane;
#pragma unroll
                    for (int h = 0; h < NH; ++h) kp[h * 192] = o;
                }
            }
        }
        if (L != 3) SEAM(P + 2);
        if (EN(3) && L == 2 && IN(P + 3)) for (int rep_ = 0; rep_ < REPS(3); ++rep_) { WSP;
            { pg8::PlainOrder S; S.init(CN, ws + W_C_UQ, 1024, 512, T, 3072, G, bx);
              pg8::EpiBf16 E{QKV, 3072};
              pg8::gemm_phase<pg8::EpiBf16, pg8::PlainOrder>(ldsl, tid, 512, 1024, 512, S, E); }
            { pg8::PlainOrder S; S.init(CN + 512, ws + W_C_UKV, 1024, 512, T, 4096, G, G - 1 - bx);
              pg8::EpiMlaKV E{KM, VM};
              pg8::gemm_phase<pg8::EpiMlaKV, pg8::PlainOrder>(ldsl, tid, 512, 1024, 512, S, E); }
        }
        if (L == 2) SEAM(P + 3);
        if (EN(5) && IN(P + 5)) for (int rep_ = 0; rep_ < REPS(5); ++rep_) { WSP;
            char* al = (char*)lds;
            bgw::NoWork nobg; bgw::Work bgwk; (void)nobg;
            {
                const int kind = (PIGGY && rep_ == 0 && L == 1) ? (SIDE_K1 && G == 256 ? 4 : 2) : 0, setsize = kind == 2 ? 65536 : (kind == 4 ? 57344 : 0);
                bgwk.kind = kind; bgwk.cur = __builtin_amdgcn_readfirstlane((int)((long)gw * setsize / NGW)); bgwk.end = __builtin_amdgcn_readfirstlane((int)((long)(gw + 1) * setsize / NGW)); bgwk.half = 0; bgwk.pending = 0;
                bgwk.ws = ws; bgwk.ptab = ptab;
                bgwk.scr = (LAS float*)(ldsl + 77824 + wave * 8448);
                bgwk.r0 = bgwk.r1 = bgwk.r2 = bgwk.r3 = (f32x4){0.f, 0.f, 0.f, 0.f};
            }
            if (L == 0) {
#pragma unroll 1
                for (int u = vcu; u < 512; u += G) {
                    const int grp = u >> 5, b = grp >> 2, kvh = grp & 3, h = kvh * 4 + ((u & 31) >> 3), qb = u & 7;
                    att::FWin f; const int q0 = qb * 256; int ks = q0 - 128; ks = ks < 0 ? 0 : ks; int ke = q0 + 384; ke = ke > SEQ ? SEQ : ke;
                    f.Kb = QKV + 2048 + kvh * HD; f.Vb = QKV + 2560 + kvh * HD; f.ldk = GQA_IN; f.ldv = GQA_IN; f.NT = (ke - ks) / 64; f.C = att::SC128 * att::LOG2E; f.thr_raw = att::THR * att::ISC128;
                    f.Q = QKV + (size_t)(b * SEQ + q0) * GQA_IN + h * HD; f.O = OB + (size_t)(b * SEQ + q0) * DM + h * HD; f.ldq = GQA_IN; f.ldo = DM; f.k0 = (long)b * SEQ + ks;
                    f.qpos0 = q0; f.kpos0 = ks; f.sink_raw = ldp(ptab, IN_A_SINK)[h] * att::ISC128;
                    __syncthreads();
#ifndef NO_ATTA
                    att::attn_unit<128, att::FWin, bgw::NoWork>(f, al, tid, nobg);
#endif
                }
            } else if (L == 1) {
#pragma unroll 1
                for (int u = vcu; u < 512; u += G) {
                    const int grp = u >> 5, b = grp >> 2, kvh = grp & 3, h = kvh * 4 + ((u & 31) >> 3), qb = u & 7;
                    att::FDense f; const int q0 = qb * 256;
                    f.Kb = QKV + 2048 + kvh * HD; f.Vb = QKV + 2560 + kvh * HD; f.ldk = GQA_IN; f.ldv = GQA_IN; f.NT = SEQ / 64; f.C = att::SC128 * att::LOG2E; f.thr_raw = att::THR * att::ISC128;
                    f.Q = QKV + (size_t)(b * SEQ + q0) * GQA_IN + h * HD; f.O = OB + (size_t)(b * SEQ + q0) * DM + h * HD; f.ldq = GQA_IN; f.ldo = DM; f.k0 = (long)b * SEQ;
                    __syncthreads();
#ifndef NO_ATTB
                    att::attn_unit<128, att::FDense, bgw::Work>(f, al, tid, bgwk);
#endif
                }
            } else if (L == 2) {
#pragma unroll 1
                for (int u = vcu; u < 512; u += G) {
                    const int grp = u >> 3, b = grp >> 4, h = grp & 15, qb = u & 7;
                    att::FMla f; const int q0 = qb * 256; f.tab = TABC; f.pos0 = q0;
                    f.Kb = KM + h * 192; f.Vb = VM + h * HD; f.ldk = 3072; f.ldv = 2048; f.NT = SEQ / 64; f.C = att::SC192 * att::LOG2E; f.thr_raw = att::THR / att::SC192;
                    f.Q = QKV + (size_t)(b * SEQ + q0) * 3072 + h * 192; f.O = OB + (size_t)(b * SEQ + q0) * DM + h * HD; f.ldq = 3072; f.ldo = DM; f.k0 = (long)b * SEQ;
                    __syncthreads();
#ifndef NO_ATTC
                    att::attn_unit<192, att::FMla, bgw::NoWork>(f, al, tid, nobg);
#endif
                }
            } else {
                float* bl = (float*)(al + 2 * 16384 + 2 * 64 * 272 + 2048);
#pragma unroll 1
                for (int u = vcu; u < 512; u += G) {
                    const int b = u >> 7, rq = (u & 127) >> 2, kvh = u & 3;
                    __syncthreads();
                    for (int i = tid; i < 4 * 465; i += 512) bl[i] = ldp(ptab, IN_D_RPB)[(size_t)(kvh * 4) * 465 + i] * att::ISC128;
                    att::FNat f; int rb = rq - 4; rb = rb < 0 ? 0 : (rb > 24 ? 24 : rb);
                    f.Kb = QKV + 2048 + kvh * HD; f.Vb = QKV + 2560 + kvh * HD; f.ldk = GQA_IN; f.ldv = GQA_IN; f.NT = 8; f.C = att::SC128 * att::LOG2E; f.thr_raw = att::THR * att::ISC128;
                    f.Q = QKV; f.O = OB; f.tok0 = (long)b * SEQ + rq * 64; f.kvh = kvh; f.rq = rq; f.rb = rb; f.bias = bl;
#ifndef NO_ATTD
                    att::attn_unit<128, att::FNat, bgw::NoWork>(f, al, tid, nobg);
#endif
                }
            }
            if (bgwk.kind) bg_drain(bgwk, (int)__builtin_amdgcn_mbcnt_hi(~0u, __builtin_amdgcn_mbcnt_lo(~0u, (unsigned)opq_s(0))));
        }
        SEAM(P + 5);
        if (EN(6) && IN(P + 6)) for (int rep_ = 0; rep_ < REPS(6); ++rep_) { WSP;
            const size_t wo = L == 0 ? W_A_OUT : (L == 1 ? W_B_OUT : (L == 2 ? W_C_OUT : W_D_OUT));
            pg8::PlainOrder S; S.init(OB, ws + wo, DM, DM, T, DM, G, bx);
            const size_t tr_ = (size_t)(args.flags & 1);
            pg8::EpiResidB16<true> E{HB, (bf16_t*)(ws + A_H + tr_ * (A_TRASH - A_H)), (float*)(ws + WS_SS2 + tr_ * (A_TRASH - WS_SS2)), DM};
            pg8::gemm_phase<pg8::EpiResidB16<true>, pg8::PlainOrder>(ldsl, tid, DM, DM, DM, S, E);
        }
        SEAM(P + 6);
        if (EN(8) && IN(P + 8)) for (int rep_ = 0; rep_ < REPS(8); ++rep_) { WSP;
            pg8::SplitKOrder S; S.A = (const char*)HB; S.Bt = (const char*)(ws + W_XQ + (size_t)L * 512 * 2048 * 2); S.lda = DM; S.ldb = DM; S.nN = XAI / 256; S.KS = 4; S.Kc = DM / 4; S.nwg = (T / 256) * (XAI / 256) * 4; S.G = G; S.c = vcu;
            pg8::EpiBf16Slab E{(bf16_t*)(ws + A_XG), XAI, (size_t)T * XAI};
            pg8::gemm_phase<pg8::EpiBf16Slab, pg8::SplitKOrder>(ldsl, tid, DM / 4, DM, DM, S, E);
            if (SIDE_DOWN && rep_ == 0 && bx >= (T / 256) * (XAI / 256)) {
                const int nidle = G - (T / 256) * (XAI / 256); LAS float* scr = (LAS float*)(ldsl + wave * 16384); const float* wd = ldp(ptab, IN_M_DOWN);
#pragma unroll 1
                for (int it = (bx - (T / 256) * (XAI / 256)) * 8 + wave; it < 16 * 1024; it += nidle * 8) { const int mat = L * 16 + (it >> 10), r = it & 1023, kb = r >> 6, n0 = (r & 63) * 32;
                    transpose_item(wd + (size_t)mat * 1024 * 2048, 2048, (bf16_t*)(ws + W_M2) + (size_t)mat * 2048 * 1024, 1024, 64 * kb, n0, n0, scr, lane, nullptr); }
            }
        }
        SEAM(P + 8);
        if (EN(9) && IN(P + 9)) for (int rep_ = 0; rep_ < REPS(9); ++rep_) { WSP;
            char* al = (char*)lds; const bf16_t* kv = KVX + (size_t)L * 1024 * 1024;
            const int xsp = G >= 256 ? G / 128 : 1;
#pragma unroll 1
            for (int u = (vcu % xsp == 0) ? vcu / xsp : 128; u < 128; u += G / xsp) {
                const int b = u >> 5, h = (u & 31) >> 3, qb = u & 7;
                att::FCross f; const int q0 = qb * 256; f.slab = (size_t)T * XAI; f.ss = SS2; f.row0g = b * SEQ + q0;
                f.Kb = kv + h * HD; f.Vb = kv + XAI + h * HD; f.ldk = 1024; f.ldv = 1024; f.NT = MEMT / 64; f.C = att::SC128 * att::LOG2E; f.thr_raw = att::THR * att::ISC128;
                f.Q = (const bf16_t*)(ws + A_XG) + (size_t)(b * SEQ + q0) * XAI + h * HD; f.O = OX + (size_t)(b * SEQ + q0) * XAI + h * HD; f.ldq = XAI; f.ldo = XAI; f.k0 = (long)b * MEMT;
                __syncthreads();
#ifndef NO_ATTX
                { bgw::NoWork nobg; att::attn_unit<128, att::FCross, bgw::NoWork>(f, al, tid, nobg); }
#endif
            }
            if (SIDE_X && rep_ == 0 && L != 1 && vcu >= 128) {
                const int nidle = G - 128; LAS float* scr = (LAS float*)(ldsl + wave * 16384); const float* wgp = ldp(ptab, IN_M_GATE); const float* gk = ldp(ptab, IN_GFFN) + L * DM;
#pragma unroll 1
                for (int it = (vcu - 128) * 8 + wave; it < 8 * 1024; it += nidle * 8) { const int mat = L * 16 + (it >> 10), r = it & 1023, kb = r >> 5, n0 = (r & 31) * 32;
                    transpose_item(wgp + (size_t)mat * 2048 * 1024, 1024, (bf16_t*)(ws + W_M1) + (size_t)mat * 2048 * 2048, 2048, 64 * kb, n0, (n0 >> 7) * 256 + (n0 & 127), scr, lane, gk); }
            }
        }
        SEAM(P + 9);
        if (EN(10) && IN(P + 10)) for (int rep_ = 0; rep_ < REPS(10); ++rep_) { WSP;
            pg8::PlainOrder S; S.init(OX, ws + W_XO + (size_t)L * 2048 * 512 * 2, XAI, XAI, T, DM, G, bx);
            pg8::EpiResidB16<false> E{HB, (bf16_t*)(ws + A_H + (size_t)(args.flags & 1) * (A_TRASH - A_H)), nullptr, DM};
            pg8::gemm_phase<pg8::EpiResidB16<false>, pg8::PlainOrder>(ldsl, tid, XAI, XAI, XAI, S, E);
        }
        SEAM(P + 10);
        if (EN(11) && IN(P + 11)) for (int rep_ = 0; rep_ < REPS(11); ++rep_) { WSP;
            LAS float* part = (LAS float*)ldsl;
            LAS float* ssl = part + 8 * 2 * 64 * 4;
            const u32x4* rwh = (const u32x4*)(ws + WS_RW) + (size_t)L * 8192 + (size_t)wave * 8 * 64 + lane; const u32x4* rwl = rwh + 4096;
            const int fr = lane & 15, fq = lane >> 4;
#pragma unroll 1
            for (int u = vcu; u < T / 32; u += G) {
                const bf16_t* ap = HB + (size_t)(u * 32 + fr) * DM + wave * 256 + fq * 8;
                u32x4 a0[8], a1[8], bh[8], bl[8];
#pragma unroll
                for (int s_ = 0; s_ < 8; ++s_) { a0[s_] = *(const u32x4*)(ap + s_ * 32); a1[s_] = *(const u32x4*)(ap + (size_t)16 * DM + s_ * 32); bh[s_] = rwh[s_ * 64]; bl[s_] = rwl[s_ * 64]; }
                __builtin_amdgcn_sched_barrier(0);
                f32x4 c0 = {0.f, 0.f, 0.f, 0.f}, c1 = {0.f, 0.f, 0.f, 0.f}; float ss0 = 0.f, ss1 = 0.f;
#pragma unroll
                for (int s_ = 0; s_ < 8; ++s_) {
                    c0 = __builtin_amdgcn_mfma_f32_16x16x32_bf16(__builtin_bit_cast(bf16x8, a0[s_]), __builtin_bit_cast(bf16x8, bh[s_]), c0, 0, 0, 0);
                    c1 = __builtin_amdgcn_mfma_f32_16x16x32_bf16(__builtin_bit_cast(bf16x8, a1[s_]), __builtin_bit_cast(bf16x8, bh[s_]), c1, 0, 0, 0);
                    c0 = __builtin_amdgcn_mfma_f32_16x16x32_bf16(__builtin_bit_cast(bf16x8, a0[s_]), __builtin_bit_cast(bf16x8, bl[s_]), c0, 0, 0, 0);
                    c1 = __builtin_amdgcn_mfma_f32_16x16x32_bf16(__builtin_bit_cast(bf16x8, a1[s_]), __builtin_bit_cast(bf16x8, bl[s_]), c1, 0, 0, 0);
#pragma unroll
                    for (int c = 0; c < 4; ++c) { const float x0 = __uint_as_float(a0[s_][c] << 16), x1 = __uint_as_float(a0[s_][c] & 0xffff0000u), y0 = __uint_as_float(a1[s_][c] << 16), y1 = __uint_as_float(a1[s_][c] & 0xffff0000u);
                        ss0 += x0 * x0 + x1 * x1; ss1 += y0 * y0 + y1 * y1; }
                }
                ss0 += __shfl_xor(ss0, 16); ss0 += __shfl_xor(ss0, 32); ss1 += __shfl_xor(ss1, 16); ss1 += __shfl_xor(ss1, 32);
                __syncthreads();
                *(LAS f32x4*)(part + ((wave * 2 + 0) * 64 + lane) * 4) = c0; *(LAS f32x4*)(part + ((wave * 2 + 1) * 64 + lane) * 4) = c1;
                if (fq == 0) { ssl[(wave * 2 + 0) * 16 + fr] = ss0; ssl[(wave * 2 + 1) * 16 + fr] = ss1; }
                __syncthreads();
                if (wave < 2) {
                    f32x4 lg = {0.f, 0.f, 0.f, 0.f}; f32x4 sq = {0.f, 0.f, 0.f, 0.f};
#pragma unroll
                    for (int w = 0; w < 8; ++w) { const f32x4 p = *(const LAS f32x4*)(part + ((w * 2 + wave) * 64 + lane) * 4); const f32x4 q = *(const LAS f32x4*)(ssl + (w * 2 + wave) * 16 + 4 * fq);
                        lg.x += p.x; lg.y += p.y; lg.z += p.z; lg.w += p.w; sq.x += q.x; sq.y += q.y; sq.z += q.z; sq.w += q.w; }
                    f32x4 rs, af;
#pragma unroll
                    for (int i = 0; i < 4; ++i) { rs[i] = 1.0f / sqrtf(sq[i] * (1.0f / DM) + EPS);
                        const float a1_ = lg[i] * rs[i];
                        float mx = a1_; mx = fmaxf(mx, __shfl_xor(mx, 1)); mx = fmaxf(mx, __shfl_xor(mx, 2)); mx = fmaxf(mx, __shfl_xor(mx, 4)); mx = fmaxf(mx, __shfl_xor(mx, 8));
                        const float ex = expf(a1_ - mx); float sum = ex; sum += __shfl_xor(sum, 1); sum += __shfl_xor(sum, 2); sum += __shfl_xor(sum, 4); sum += __shfl_xor(sum, 8);
                        af[i] = ex / sum; }
                    const int t = u * 32 + wave * 16 + 4 * fq;
                    *(f32x4*)(AFF + ((size_t)(t / SEQ) * NE + fr) * SEQ + (t % SEQ)) = af;
                    if (fr == 0) *(f32x4*)(RS3 + t) = rs;
                }
            }
            __syncthreads();
        }
        SEAM(P + 11);
        if (EN(12) && IN(P + 12)) for (int rep_ = 0; rep_ < REPS(12); ++rep_) { WSP;
            volatile LAS int* cnt = (volatile LAS int*)ldsl;
            const int stride = G >= 64 ? G / 64 : 1;
            if (vcu % stride == 0) {
#pragma unroll 1
                for (int u = vcu / stride; u < NB * NE; u += (G + stride - 1) / stride) {
                    const int b = u >> 4, e = u & 15; const float* ap = AFF + (size_t)u * SEQ + wave * 256;
                    unsigned kk[4];
#pragma unroll
                    for (int i = 0; i < 4; ++i) kk[i] = __float_as_uint(ap[lane + 64 * i]);
                    __syncthreads();
                    unsigned tau = 0u;
#pragma unroll 1
                    for (int sh = 28, stepi = 0; sh >= 0; sh -= 4, ++stepi) { int mine = 0;
#pragma unroll
                        for (int j = 1; j < 16; ++j) { const unsigned cand = tau | ((unsigned)j << sh); int c = 0;
#pragma unroll
                            for (int i = 0; i < 4; ++i) c += __builtin_popcountll(__ballot(kk[i] >= cand));
                            asm volatile("v_writelane_b32 %0, %1, %2" : "+v"(mine) : "s"(c), "n"(j)); }
                        const int pb = 64 + (stepi & 1) * 128; if (lane < 16) cnt[pb + wave * 16 + lane] = mine;
                        __syncthreads();
                        int tot = 0;
#pragma unroll
                        for (int w = 0; w < 8; ++w) tot += cnt[pb + w * 16 + (lane & 15)];
                        tau |= (unsigned)__builtin_popcountll(__ballot(lane >= 1 && lane < 16 && tot >= CAP)) << sh; }
                    int ngt_w = 0, neq_w = 0;
#pragma unroll
                    for (int i = 0; i < 4; ++i) { ngt_w += __builtin_popcountll(__ballot(kk[i] > tau)); neq_w += __builtin_popcountll(__ballot(kk[i] == tau)); }
                    if (lane == 0) { cnt[16 + wave] = ngt_w; cnt[24 + wave] = neq_w; }
                    __syncthreads();
                    int ngt = 0, eqbase = 0;
#pragma unroll
                    for (int w = 0; w < 8; ++w) { ngt += cnt[16 + w]; eqbase += (w < wave) ? cnt[24 + w] : 0; }
                    const int need = CAP - ngt;
                    bool sel[4]; int nsel_w = 0, eqrun = eqbase;
#pragma unroll
                    for (int i = 0; i < 4; ++i) { const bool gt = kk[i] > tau, eq = kk[i] == tau; const unsigned long long eqm = __ballot(eq);
                        const int eqr = eqrun + (int)__builtin_amdgcn_mbcnt_hi((unsigned)(eqm >> 32), __builtin_amdgcn_mbcnt_lo((unsigned)eqm, 0u));
                        sel[i] = gt || (eq && eqr < need); nsel_w += __builtin_popcountll(__ballot(sel[i])); eqrun += __builtin_popcountll(eqm); }
                    if (lane == 0) cnt[32 + wave] = nsel_w;
                    __syncthreads();
                    int selbase = 0;
#pragma unroll
                    for (int w = 0; w < 8; ++w) selbase += (w < wave) ? cnt[32 + w] : 0;
                    const int srow = u * CAP;
#pragma unroll
                    for (int i = 0; i < 4; ++i) { const unsigned long long selm = __ballot(sel[i]);
                        const int slot = selbase + (int)__builtin_amdgcn_mbcnt_hi((unsigned)(selm >> 32), __builtin_amdgcn_mbcnt_lo((unsigned)selm, 0u));
                        const int t = wave * 256 + 64 * i + lane;
                        if (sel[i]) { IDX[srow + slot] = b * SEQ + t; GATE[srow + slot] = __uint_as_float(kk[i]); RSG[srow + slot] = RS3[b * SEQ + t]; }
                        SLOT[((size_t)b * SEQ + t) * NE + e] = sel[i] ? slot : -1;
                        selbase += __builtin_popcountll(selm); }
                }
            }
            __syncthreads();
        }
        SEAM(P + 12);
        if (EN(13) && IN(P + 13)) for (int rep_ = 0; rep_ < REPS(13); ++rep_) { WSP;
            pg8::MoeGatherOrder S; S.rows = IDX; S.A = (const char*)HB; S.Bt = (const char*)(ws + W_M1 + (size_t)L * 16 * 2048 * 2048 * 2); S.lda = DM; S.ldb = DM; S.G = G; S.vcu = vcu; S.bstride = (size_t)2048 * 2048 * 2;
            pg8::EpiSwiGLU E{HMID, RSG, GATE};
            pg8::gemm_phase<pg8::EpiSwiGLU, pg8::MoeGatherOrder>(ldsl, tid, DM, DM, DM, S, E);
        }
        SEAM(P + 13);
        if (EN(14) && IN(P + 14)) for (int rep_ = 0; rep_ < REPS(14); ++rep_) { WSP;
            pg8::MoeOrder S; S.A = (const char*)HMID; S.Bt = (const char*)(ws + W_M2 + (size_t)L * 16 * 2048 * 1024 * 2); S.lda = FF; S.ldb = FF; S.G = G; S.vcu = vcu; S.bstride = (size_t)2048 * 1024 * 2;
            pg8::EpiBf16 E{YB, DM};
            pg8::gemm_phase<pg8::EpiBf16, pg8::MoeOrder>(ldsl, tid, FF, FF, FF, S, E);
        }
        SEAM(P + 14);
    }
    if (XTRA_BAR && IN(PH_FINAL) && lo < PH_FINAL) { for (int i_ = 0; i_ < XTRA_BAR; ++i_) xcd_barrier(bar, TID0); }
    if (EN(16) && IN(PH_FINAL)) for (int rep_ = 0, L_ = 0; rep_ < REPS(16); ++rep_) { WSP;
        RowPre cur; if (gw < T) rowpre_load(cur, HB + (size_t)gw * DM, SLOT + (size_t)gw * NE, lane);
#pragma unroll 1
        for (int t = gw; t < T; t += NGW) {
            RowPre nx = cur; const int tn = t + NGW; if (tn < T) rowpre_load(nx, HB + (size_t)tn * DM, SLOT + (size_t)tn * NE, lane);
            f32x4 v[8]; rowpre_unpack(cur, v); const int myslot = cur.slot; cur = nx;
            row_combine_s(v, myslot, YB, t / SEQ, lane);
            const float rstd = row_rstd(v); const float* g = ldp(ptab, IN_FINALG);
#pragma unroll
            for (int j = 0; j < 8; ++j) { const f32x4 gg = *(const f32x4*)(g + 4 * lane + 256 * j);
                *(f32x4*)(args.out + (size_t)t * DM + 4 * lane + 256 * j) = (f32x4){v[j].x * rstd * gg.x, v[j].y * rstd * gg.y, v[j].z * rstd * gg.z, v[j].w * rstd * gg.w}; }
        }
    }
#undef IN
#undef SEAM
#undef H
}

#ifndef EXP_PHASE
#define EXP_PHASE -1
#endif
#ifndef EXP_REPS
#define EXP_REPS 8
#endif
static bool phase_nonempty(int p) {
    if (p == 0 || p == PH_FINAL) return true;
    const int L = (p - 1) / PH_PER_LAYER, k = (p - 1) % PH_PER_LAYER;
    if (k == 0) return L > 0;
    if (k == 2) return L != 3;
    if (k == 3) return L == 2;
    if (k == 4) return false;
    if (k == 7) return false;
    return true;
}
extern "C" void kernel_launch(void* const* d_in, const int* in_sizes, int n_in, void* d_out, int out_size, void* d_ws, size_t ws_size, hipStream_t stream) {
    static int grid = 0;
    if (grid == 0) {
        if (n_in != 30 || out_size != T * DM || ws_size < WS_END) { fprintf(stderr, "kernel_launch: unexpected shapes (n_in %d, out %d, ws %zu < %zu); nothing launched\n", n_in, out_size, ws_size, (size_t)WS_END); grid = -1; return; }
        int dev = 0, cus = 0, per_cu = 0;
        if (hipGetDevice(&dev) != hipSuccess || hipDeviceGetAttribute(&cus, hipDeviceAttributeMultiprocessorCount, dev) != hipSuccess) { grid = -1; return; }
        if (hipFuncSetAttribute((const void*)fwd, hipFuncAttributeMaxDynamicSharedMemorySize, LDS_BYTES) != hipSuccess) { fprintf(stderr, "kernel_launch: hipFuncSetAttribute failed\n"); grid = -1; return; }
        if (hipOccupancyMaxActiveBlocksPerMultiprocessor(&per_cu, (const void*)fwd, 512, LDS_BYTES) != hipSuccess || per_cu < 1) { fprintf(stderr, "kernel_launch: occupancy query says %d\n", per_cu); }
        (void)hipGetLastError();
        grid = cus;
    }
    if (grid < 0) return;
    (void)hipMemsetAsync((char*)d_ws + WS_CTL, 0, CTL_BYTES, stream);
    Args a{};
    for (int i = 0; i < 30; ++i) a.in[i] = (const float*)d_in[i];
    a.out = (float*)d_out; a.ws = (unsigned char*)d_ws;
#if MK_SINGLE
    a.ph_lo = 0; a.ph_hi = N_PHASES;
    hipLaunchKernelGGL(fwd, dim3(grid), dim3(512), LDS_BYTES, stream, a);
#else
    for (int p = 0; p < N_PHASES; ++p) {
        if (!phase_nonempty(p)) continue;
        a.ph_lo = p; a.ph_hi = p + 1; a.flags = 0;
        hipLaunchKernelGGL(fwd, dim3(grid), dim3(512), LDS_BYTES, stream, a);
        if (p == EXP_PHASE) { const int k = (p - 1) % PH_PER_LAYER; a.flags = (p > 0 && p < PH_FINAL && (k == 0 || k == 6 || k == 10)) ? 1 : 0;
            for (int r = 0; r < EXP_REPS; ++r) hipLaunchKernelGGL(fwd, dim3(grid), dim3(512), LDS_BYTES, stream, a); }
    }
#endif
    const hipError_t le = hipPeekAtLastError();
    if (le != hipSuccess) fprintf(stderr, "kernel_launch: launch failed: %s\n", hipGetErrorName(le));
}
```

```cpp
#include <hip/hip_runtime.h>
#include <cstdio>
#include <cstdint>

#ifndef MK_SINGLE
#define MK_SINGLE 1
#endif

#ifndef PHMASK
#define PHMASK 0xFFFFFu
#endif
#ifndef ATT2A
#define ATT2A att::attn_unit
#endif
#ifndef ATT2B
#define ATT2B att::attn_unit
#endif
#ifndef ATT2C
#define ATT2C att::attn_unit
#endif
#ifndef ATT2D
#define ATT2D att::attn_unit
#endif
#ifndef SIDE_X
#define SIDE_K1 1
#define SIDE_X 0
#endif
#ifndef PIGGY
#define PIGGY 1
#endif
#ifndef SIDE_DOWN
#define SIDE_DOWN 0
#endif
#ifndef BG_CONVERT
#define BG_CONVERT 0
#endif
#define EN(k) (((PHMASK) >> (k)) & 1u)
#ifndef REP_MASK
#define REP_MASK 0x0u
#endif
#ifndef REP_LMASK
#define REP_LMASK 0xFu
#endif
#ifndef XTRA_BAR
#define XTRA_BAR 0
#endif
#define REPS(k) (((((REP_MASK) >> (k)) & 1u) && (((REP_LMASK) >> (L_)) & 1u)) ? 2 : 1)
#define LAS __attribute__((address_space(3)))
typedef unsigned short bf16_t;
typedef short bf16x8 __attribute__((ext_vector_type(8)));
typedef short s16x4 __attribute__((ext_vector_type(4)));
typedef float f32x4 __attribute__((ext_vector_type(4)));
typedef float f32x16 __attribute__((ext_vector_type(16)));
typedef unsigned u32x4 __attribute__((ext_vector_type(4)));
typedef unsigned u32x2 __attribute__((ext_vector_type(2)));

__device__ __forceinline__ unsigned cvtpk(float lo, float hi) { unsigned r; asm volatile("v_cvt_pk_bf16_f32 %0, %1, %2" : "=v"(r) : "v"(lo), "v"(hi)); return r; }
__device__ __forceinline__ float bf2f(unsigned b) { return __uint_as_float(b << 16); }
__device__ __forceinline__ bf16_t f2bf(float f) { return (bf16_t)(cvtpk(f, f) & 0xffffu); }
template <class TP> __device__ __forceinline__ TP* opaque(TP* p) { unsigned long long v = (unsigned long long)p; asm volatile("" : "+s"(v)); return (TP*)(__attribute__((address_space(1))) TP*)v; }
#define GAS __attribute__((address_space(1)))
__device__ __forceinline__ const float* ldp(volatile LAS unsigned long long* t, int i) { const unsigned long long v = t[i]; const unsigned lo = __builtin_amdgcn_readfirstlane((unsigned)v), hi = __builtin_amdgcn_readfirstlane((unsigned)(v >> 32));
    const GAS float* g = (const GAS float*)(((unsigned long long)hi << 32) | lo); return (const float*)g; }
__device__ __forceinline__ int opq_v(int v) { asm volatile("" : "+v"(v)); return v; }
__device__ __forceinline__ int opq_s(int v) { asm volatile("" : "+s"(v)); return v; }
__device__ __forceinline__ float wave_sum(float v) {
#pragma unroll
    for (int o = 1; o < 64; o <<= 1) v += __shfl_xor(v, o);
    return v;
}

constexpr int NB = 4, SEQ = 2048, T = NB * SEQ, DM = 2048, NH = 16, NKV = 4, HD = 128, GQA_IN = 3072;
constexpr int MLA_IN = 1088, MLA_INP = 1280, MEMT = 256, XAI = 512, NE = 16, CAP = 256, FF = 1024, NSLOT = NB * NE * CAP;
constexpr float EPS = 1e-6f;

constexpr size_t MiB = 1u << 20;
constexpr size_t al256(size_t x) { return (x + 255) & ~(size_t)255; }
constexpr size_t WS_CTL = 0, CTL_BYTES = 64 * 1024;
constexpr size_t WS_TABA = 1 * MiB;
constexpr size_t WS_TABBR = WS_TABA + 2048 * 16 * 2 * 4;
constexpr size_t WS_TABBC = WS_TABBR + 32 * 32 * 2 * 4;
constexpr size_t WS_TABC = WS_TABBC + 64 * 32 * 2 * 4;
constexpr size_t WS_AFF = 2 * MiB;
constexpr size_t WS_IDX = WS_AFF + (size_t)NB * NE * SEQ * 4;
constexpr size_t WS_GATE = WS_IDX + (size_t)NSLOT * 4;
constexpr size_t WS_SLOT = WS_GATE + (size_t)NSLOT * 4;
constexpr size_t WS_SS2 = 3 * MiB;
constexpr size_t WS_RS1 = 2 * MiB + 1280 * 1024, WS_RS3 = WS_RS1 + (size_t)T * 4;
constexpr size_t WS_RSG = WS_RS3 + (size_t)T * 4;
constexpr size_t WS_W = 4 * MiB;
constexpr size_t W_A_IN = WS_W, W_A_OUT = W_A_IN + (size_t)3072 * 2048 * 2, W_B_IN = W_A_OUT + (size_t)2048 * 2048 * 2, W_B_OUT = W_B_IN + (size_t)3072 * 2048 * 2;
constexpr size_t W_D_IN = W_B_OUT + (size_t)2048 * 2048 * 2, W_D_OUT = W_D_IN + (size_t)3072 * 2048 * 2;
constexpr size_t W_C_IN = W_D_OUT + (size_t)2048 * 2048 * 2, W_C_UQ = W_C_IN + (size_t)MLA_INP * 2048 * 2, W_C_UKV = W_C_UQ + (size_t)3072 * 512 * 2, W_C_OUT = W_C_UKV + (size_t)4096 * 512 * 2;
constexpr size_t W_XQ = W_C_OUT + (size_t)2048 * 2048 * 2, W_XKV = W_XQ + (size_t)4 * 512 * 2048 * 2, W_XO = W_XKV + (size_t)4 * 1024 * 2048 * 2;
constexpr size_t W_M1 = W_XO + (size_t)4 * 2048 * 512 * 2, W_M2 = W_M1 + (size_t)64 * 2048 * 2048 * 2, W_END = W_M2 + (size_t)64 * 2048 * 1024 * 2;
constexpr size_t A_H = al256(W_END), A_XN = A_H + (size_t)T * DM * 4, A_QKV = A_XN + (size_t)T * DM * 2, A_KM = A_QKV + (size_t)T * 3072 * 2, A_VM = A_KM + (size_t)T * 3072 * 2;
constexpr size_t A_LAT = A_VM + (size_t)T * 2048 * 2, A_CN = A_LAT + (size_t)T * MLA_INP * 4, A_O = A_CN + (size_t)T * 1024 * 2, A_QX = A_O + (size_t)T * DM * 2, A_OX = A_QX + (size_t)T * XAI * 2;
constexpr size_t A_KVX = A_OX + (size_t)T * XAI * 2, A_MEMN = A_KVX + (size_t)4 * 1024 * 1024 * 2, A_XG = A_MEMN + (size_t)1024 * 2048 * 2, A_HMID = A_XG + (size_t)NSLOT * DM * 2;
constexpr size_t A_Y = A_HMID + (size_t)NSLOT * FF * 2, WS_END = A_Y + (size_t)NSLOT * DM * 2;
constexpr size_t WS_RW = A_XN;
constexpr size_t A_TRASH = A_XG;

constexpr int RING_BYTES = 131072, LDS_BYTES = 163840, LDSCTL_OFF = LDS_BYTES - 1024;

#define XB_TMO      128
#define XB_XCNT(j)  (256  + 64 * (j))
#define XB_XSUB(j)  (1280 + 64 * (j))
#define XB_XGEN(j)  (2304 + 64 * (j))
#define XB_TOP      3328
#define XB_TOPGEN   3392
#define XCD_BAR_WORDS 3456
#define XB_SPIN_CAP (1u << 18)

__device__ __forceinline__ unsigned xb_ld(unsigned* p)              { return __hip_atomic_load(p, __ATOMIC_RELAXED, __HIP_MEMORY_SCOPE_AGENT); }
__device__ __forceinline__ unsigned xb_add(unsigned* p, unsigned v) { return __hip_atomic_fetch_add(p, v, __ATOMIC_RELAXED, __HIP_MEMORY_SCOPE_AGENT); }
__device__ __forceinline__ unsigned xb_xcc_id() { return (unsigned)__builtin_amdgcn_s_getreg((3 << 11) | 20) & 0xFu; }
#define XB_SPIN(cond, bar) do { unsigned _sp = 0; while (cond) { __builtin_amdgcn_s_sleep(1); \
    if ((++_sp & 255u) == 0u) { if (xb_ld(&(bar)[XB_TMO])) break; if (_sp > XB_SPIN_CAP) { atomicAdd(&(bar)[XB_TMO], 1u); break; } } } } while (0)

struct XcdBarrier { unsigned* bar; unsigned x; volatile LAS unsigned* st; };

__device__ __forceinline__ XcdBarrier xcd_barrier_post(unsigned* bar, volatile LAS unsigned* st, const int tid) {
    XcdBarrier b; b.bar = bar; b.x = xb_xcc_id(); b.st = st;
    if (tid == 0) (void)xb_add(&bar[XB_XCNT(b.x)], 1u);
    return b;
}
__device__ __forceinline__ void xcd_barrier_complete(unsigned* bar, unsigned x, unsigned& nloc, unsigned& nx) {
    const unsigned G = gridDim.x * gridDim.y * gridDim.z;
    unsigned sum, cnt, mine, sp = 0u;
    for (;;) {
        sum = 0u; cnt = 0u; mine = 0u;
#pragma unroll
        for (unsigned j = 0; j < 16; ++j) { const unsigned c = xb_ld(&bar[XB_XCNT(j)]); sum += c; cnt += (c > 0u) ? 1u : 0u; mine = (j == x) ? c : mine; }
        if (sum == G) break;
        __builtin_amdgcn_s_sleep(1);
        if ((++sp & 255u) == 0u) { if (xb_ld(&bar[XB_TMO])) break; if (sp > XB_SPIN_CAP) { atomicAdd(&bar[XB_TMO], 1u); break; } }
    }
    nloc = mine > 0u ? mine : 1u; nx = cnt > 0u ? cnt : 1u;
}
__device__ __forceinline__ void xcd_barrier(const XcdBarrier& b, const int tid) {
    asm volatile("s_waitcnt vmcnt(0)" ::: "memory");
    __syncthreads();
    if (tid == 0) {
        unsigned* bar = b.bar;
        __builtin_amdgcn_s_waitcnt(0);
        unsigned nloc = b.st[0], nx = b.st[1];
        if (nloc == 0u) { xcd_barrier_complete(bar, b.x, nloc, nx); b.st[0] = nloc; b.st[1] = nx; }
        const unsigned old = xb_add(&bar[XB_XSUB(b.x)], 1u);
        const unsigned gen = old / nloc;
        if (old + 1u == (gen + 1u) * nloc) {
            __builtin_amdgcn_fence(__ATOMIC_RELEASE, "agent");
            asm volatile("s_waitcnt vmcnt(0)" ::: "memory");
            const unsigned og = xb_add(&bar[XB_TOP], 1u);
            const unsigned tg = og / nx;
            if (og + 1u == (tg + 1u) * nx) xb_add(&bar[XB_TOPGEN], 1u);
            else XB_SPIN(xb_ld(&bar[XB_TOPGEN]) == tg, bar);
            __builtin_amdgcn_fence(__ATOMIC_ACQUIRE, "agent");
            xb_add(&bar[XB_XGEN(b.x)], 1u);
            asm volatile("s_waitcnt vmcnt(0)" ::: "memory");
        } else {
            XB_SPIN(xb_ld(&bar[XB_XGEN(b.x)]) == gen, bar);
            __builtin_amdgcn_fence(__ATOMIC_ACQUIRE, "agent");
            asm volatile("s_waitcnt vmcnt(0)" ::: "memory");
        }
    }
    __syncthreads();
}

namespace pg8 {
constexpr int BM = 256, BK = 64, HALF = 128, HTB = HALF * BK * 2, STAGE_BYTES = 8 * HTB, NXCD = 8, WGM = 8;
__host__ __device__ __forceinline__ int lds_byte(int r, int c) { const int st = (r >> 4) * 2 + (c >> 5), rr = r & 15, cc = c & 31, ob = rr * 64 + cc * 2; return st * 1024 + (ob ^ (((ob >> 9) & 1) << 5)); }
__host__ __device__ __forceinline__ void stage_rc(int b, int& R, int& C) { const int st = b / 1024, sb = b % 1024, swz = sb ^ (((sb >> 9) & 1) << 5); R = (st >> 1) * 16 + swz / 64; C = (st & 1) * 32 + (swz % 64) / 2; }
__host__ __device__ __forceinline__ int perm32(int rho) { const int n = rho >> 4, i = rho & 15; return 8 * (i >> 2) + 4 * n + (i & 3); }

struct Unit { const char* a; const char* b; int pm, pn, aux; };

struct PlainOrder {
    static constexpr bool GATHER = false; const int* rows = nullptr;
    const char* A; const char* Bt; int lda, ldb, nM, nN, nwg, G, c;
    __device__ void init(const void* A_, const void* Bt_, int lda_, int ldb_, int M, int N, int G_, int c_) { A = (const char*)A_; Bt = (const char*)Bt_; lda = lda_; ldb = ldb_; nM = M / BM; nN = N / BM; nwg = nM * nN; G = G_; c = c_; }
    __device__ bool next(int i, Unit& u) const {
        const long L = (long)i * G + c; if (L >= nwg) return false;
        int wgid = (int)L; { const int q = nwg / NXCD, r = nwg % NXCD, xcd = wgid % NXCD, off = wgid / NXCD; wgid = (xcd < r ? xcd * (q + 1) : r * (q + 1) + (xcd - r) * q) + off; }
        const int nig = WGM * nN, gid = wgid / nig, fm = gid * WGM, gsz = (nM - fm) < WGM ? (nM - fm) : WGM;
        u.pm = fm + ((wgid % nig) % gsz); u.pn = (wgid % nig) / gsz;
        u.a = A + (size_t)u.pm * BM * lda * 2; u.b = Bt + (size_t)u.pn * BM * ldb * 2; return true;
    }
};
struct SplitKOrder {
    static constexpr bool GATHER = false; const int* rows = nullptr;
    const char* A; const char* Bt; int lda, ldb, nN, KS, Kc, nwg, G, c;
    __device__ bool next(int i, Unit& u) const {
        const int L = i * G + c; if (L >= nwg) return false;
        const int per = nN * KS; u.pm = L / per; const int r = L % per; u.pn = r / KS; u.aux = r % KS;
        u.a = A + (size_t)u.pm * BM * lda * 2 + (size_t)u.aux * Kc * 2; u.b = Bt + (size_t)u.pn * BM * ldb * 2 + (size_t)u.aux * Kc * 2; return true;
    }
};
struct MoeOrder {
    static constexpr bool GATHER = false; const int* rows = nullptr;
    const char* A; const char* Bt; int lda, ldb, G, vcu; size_t bstride;
    __device__ bool next(int i, Unit& u) const {
        const int L = i * G + vcu; if (L >= 512) return false;
        const int e = L >> 5, b = L & 3, pn = (L & 31) >> 2;
        u.pm = b * 16 + e; u.pn = pn;
        u.a = A + (size_t)u.pm * BM * lda * 2; u.b = Bt + (size_t)e * bstride + (size_t)pn * BM * ldb * 2; return true;
    }
};
struct MoeGatherOrder {
    static constexpr bool GATHER = true; const int* rows;
    const char* A; const char* Bt; int lda, ldb, G, vcu; size_t bstride;
    __device__ bool next(int i, Unit& u) const {
        const int L = i * G + vcu; if (L >= 512) return false;
        const int e = L >> 5, b = L & 3, pn = (L & 31) >> 2;
        u.pm = b * 16 + e; u.pn = pn;
        u.a = A; u.b = Bt + (size_t)e * bstride + (size_t)pn * BM * ldb * 2; return true;
    }
};

struct EpiBf16 {
    static constexpr bool PERM = true;
    bf16_t* O; int ldc;
    __device__ __forceinline__ void operator()(const f32x4 (&acc)[2][2][4][2], const Unit& u, int wr, int wc, int fr, int fq) const {
        const int row0 = u.pm * BM + wr * 64 + fr, col0 = u.pn * BM + wc * 32 + 8 * fq;
#pragma unroll
        for (int ai = 0; ai < 2; ++ai)
#pragma unroll
            for (int m = 0; m < 4; ++m) { bf16_t* rowp = O + (size_t)(row0 + ai * HALF + m * 16) * ldc + col0;
#pragma unroll
                for (int bj = 0; bj < 2; ++bj) { const f32x4 v0 = acc[ai][bj][m][0], v1 = acc[ai][bj][m][1];
                    u32x4 w; w.x = cvtpk(v0[0], v0[1]); w.y = cvtpk(v0[2], v0[3]); w.z = cvtpk(v1[0], v1[1]); w.w = cvtpk(v1[2], v1[3]);
                    *(u32x4*)(rowp + bj * HALF) = w; } }
    }
};
struct EpiMlaKV {
    static constexpr bool PERM = true;
    bf16_t* KM; bf16_t* VM;
    __device__ __forceinline__ void operator()(const f32x4 (&acc)[2][2][4][2], const Unit& u, int wr, int wc, int fr, int fq) const {
        const int row0 = u.pm * BM + wr * 64 + fr, c0 = wc * 32 + 8 * fq;
#pragma unroll
        for (int ai = 0; ai < 2; ++ai)
#pragma unroll
            for (int m = 0; m < 4; ++m) { const size_t row = (size_t)(row0 + ai * HALF + m * 16);
#pragma unroll
                for (int bj = 0; bj < 2; ++bj) { const f32x4 v0 = acc[ai][bj][m][0], v1 = acc[ai][bj][m][1];
                    u32x4 w; w.x = cvtpk(v0[0], v0[1]); w.y = cvtpk(v0[2], v0[3]); w.z = cvtpk(v1[0], v1[1]); w.w = cvtpk(v1[2], v1[3]);
                    bf16_t* p = bj == 0 ? KM + row * 3072 + u.pn * 192 + c0 : VM + row * 2048 + u.pn * 128 + c0;
                    *(u32x4*)p = w; } }
    }
};
struct EpiF32 {
    static constexpr bool PERM = false;
    float* C; int ldc;
    __device__ __forceinline__ void operator()(const f32x4 (&acc)[2][2][4][2], const Unit& u, int wr, int wc, int fr, int fq) const {
        const int row0 = u.pm * BM + wr * 64 + fr, col0 = u.pn * BM + wc * 32 + 4 * fq;
#pragma unroll
        for (int ai = 0; ai < 2; ++ai)
#pragma unroll
            for (int m = 0; m < 4; ++m) { float* rowp = C + (size_t)(row0 + ai * HALF + m * 16) * ldc + col0;
#pragma unroll
                for (int bj = 0; bj < 2; ++bj)
#pragma unroll
                    for (int n = 0; n < 2; ++n) *(f32x4*)(rowp + bj * HALF + n * 16) = acc[ai][bj][m][n]; }
    }
};
struct EpiResid {
    static constexpr bool PERM = false;
    const float* Hin; float* Hout; int ld;
    __device__ __forceinline__ void operator()(const f32x4 (&acc)[2][2][4][2], const Unit& u, int wr, int wc, int fr, int fq) const {
        const int row0 = u.pm * BM + wr * 64 + fr, col0 = u.pn * BM + wc * 32 + 4 * fq;
#pragma unroll
        for (int ai = 0; ai < 2; ++ai)
#pragma unroll
            for (int m = 0; m < 4; ++m) { const size_t off = (size_t)(row0 + ai * HALF + m * 16) * ld + col0;
                f32x4 r[2][2];
#pragma unroll
                for (int bj = 0; bj < 2; ++bj)
#pragma unroll
                    for (int n = 0; n < 2; ++n) r[bj][n] = *(const f32x4*)(Hin + off + bj * HALF + n * 16);
#pragma unroll
                for (int bj = 0; bj < 2; ++bj)
#pragma unroll
                    for (int n = 0; n < 2; ++n) *(f32x4*)(Hout + off + bj * HALF + n * 16) = r[bj][n] + acc[ai][bj][m][n]; }
    }
};
struct EpiResidHB {
    static constexpr bool PERM = false;
    const float* Hin; float* Hout; bf16_t* HB; float* ss; int ld;
    __device__ __forceinline__ void operator()(const f32x4 (&acc)[2][2][4][2], const Unit& u, int wr, int wc, int fr, int fq) const {
        const int row0 = u.pm * BM + wr * 64 + fr, col0 = u.pn * BM + wc * 32 + 4 * fq;
#pragma unroll
        for (int ai = 0; ai < 2; ++ai)
#pragma unroll
            for (int m = 0; m < 4; ++m) { const int row = row0 + ai * HALF + m * 16; const size_t off = (size_t)row * ld + col0;
                f32x4 r[2][2]; float sq = 0.f;
#pragma unroll
                for (int bj = 0; bj < 2; ++bj)
#pragma unroll
                    for (int n = 0; n < 2; ++n) r[bj][n] = *(const f32x4*)(Hin + off + bj * HALF + n * 16);
#pragma unroll
                for (int bj = 0; bj < 2; ++bj)
#pragma unroll
                    for (int n = 0; n < 2; ++n) { const f32x4 v = r[bj][n] + acc[ai][bj][m][n]; *(f32x4*)(Hout + off + bj * HALF + n * 16) = v;
                        u32x2 w; w.x = cvtpk(v[0], v[1]); w.y = cvtpk(v[2], v[3]); *(u32x2*)(HB + off + bj * HALF + n * 16) = w;
                        sq += (v[0] * v[0] + v[1] * v[1]) + (v[2] * v[2] + v[3] * v[3]); }
                sq += __shfl_xor(sq, 16); sq += __shfl_xor(sq, 32);
                if (fq == 0) ss[(size_t)row * 32 + u.pn * 4 + wc] = sq; }
    }
};
struct EpiBf16RS {
    static constexpr bool PERM = true;
    bf16_t* O; int ldc; const float* ss;
    __device__ __forceinline__ void operator()(const f32x4 (&acc)[2][2][4][2], const Unit& u, int wr, int wc, int fr, int fq) const {
        const int row0 = u.pm * BM + wr * 64 + fr, col0 = u.pn * BM + wc * 32 + 8 * fq;
#pragma unroll
        for (int ai = 0; ai < 2; ++ai)
#pragma unroll
            for (int m = 0; m < 4; ++m) { const int row = row0 + ai * HALF + m * 16; float sq = 0.f;
#pragma unroll
                for (int i = 0; i < 8; ++i) { const f32x4 p = *(const f32x4*)(ss + (size_t)row * 32 + 4 * i); sq += (p[0] + p[1]) + (p[2] + p[3]); }
                const float rs = 1.0f / sqrtf(sq * (1.0f / DM) + EPS); bf16_t* rowp = O + (size_t)row * ldc + col0;
#pragma unroll
                for (int bj = 0; bj < 2; ++bj) { const f32x4 v0 = acc[ai][bj][m][0] * rs, v1 = acc[ai][bj][m][1] * rs;
                    u32x4 w; w.x = cvtpk(v0[0], v0[1]); w.y = cvtpk(v0[2], v0[3]); w.z = cvtpk(v1[0], v1[1]); w.w = cvtpk(v1[2], v1[3]);
                    *(u32x4*)(rowp + bj * HALF) = w; } }
    }
};
struct EpiBf16RS1 {
    static constexpr bool PERM = true;
    bf16_t* O; int ldc; const float* rs;
    __device__ __forceinline__ void operator()(const f32x4 (&acc)[2][2][4][2], const Unit& u, int wr, int wc, int fr, int fq) const {
        const int row0 = u.pm * BM + wr * 64 + fr, col0 = u.pn * BM + wc * 32 + 8 * fq;
#pragma unroll
        for (int ai = 0; ai < 2; ++ai)
#pragma unroll
            for (int m = 0; m < 4; ++m) { const int row = row0 + ai * HALF + m * 16; const float r = rs[row]; bf16_t* rowp = O + (size_t)row * ldc + col0;
#pragma unroll
                for (int bj = 0; bj < 2; ++bj) { const f32x4 v0 = acc[ai][bj][m][0] * r, v1 = acc[ai][bj][m][1] * r;
                    u32x4 w; w.x = cvtpk(v0[0], v0[1]); w.y = cvtpk(v0[2], v0[3]); w.z = cvtpk(v1[0], v1[1]); w.w = cvtpk(v1[2], v1[3]);
                    *(u32x4*)(rowp + bj * HALF) = w; } }
    }
};
struct EpiF32RS1 {
    static constexpr bool PERM = false;
    float* C; int ldc; const float* rs;
    __device__ __forceinline__ void operator()(const f32x4 (&acc)[2][2][4][2], const Unit& u, int wr, int wc, int fr, int fq) const {
        const int row0 = u.pm * BM + wr * 64 + fr, col0 = u.pn * BM + wc * 32 + 4 * fq;
#pragma unroll
        for (int ai = 0; ai < 2; ++ai)
#pragma unroll
            for (int m = 0; m < 4; ++m) { const int row = row0 + ai * HALF + m * 16; const float r = rs[row]; float* rowp = C + (size_t)row * ldc + col0;
#pragma unroll
                for (int bj = 0; bj < 2; ++bj)
#pragma unroll
                    for (int n = 0; n < 2; ++n) *(f32x4*)(rowp + bj * HALF + n * 16) = acc[ai][bj][m][n] * r; }
    }
};
template <bool WITH_SS> struct EpiResidB16 {
    static constexpr bool PERM = true;
    const bf16_t* Hin; bf16_t* Hout; float* ss; int ld;
    __device__ __forceinline__ void operator()(const f32x4 (&acc)[2][2][4][2], const Unit& u, int wr, int wc, int fr, int fq) const {
        const int row0 = u.pm * BM + wr * 64 + fr, col0 = u.pn * BM + wc * 32 + 8 * fq;
#pragma unroll
        for (int ai = 0; ai < 2; ++ai)
#pragma unroll
            for (int m = 0; m < 4; ++m) { const int row = row0 + ai * HALF + m * 16; const size_t off = (size_t)row * ld + col0;
                u32x4 h[2]; float sq = 0.f;
#pragma unroll
                for (int bj = 0; bj < 2; ++bj) h[bj] = *(const u32x4*)(Hin + off + bj * HALF);
#pragma unroll
                for (int bj = 0; bj < 2; ++bj) { const f32x4 a0 = acc[ai][bj][m][0], a1 = acc[ai][bj][m][1];
                    const float v0 = bf2f(h[bj].x & 0xffffu) + a0[0], v1 = bf2f(h[bj].x >> 16) + a0[1], v2 = bf2f(h[bj].y & 0xffffu) + a0[2], v3 = bf2f(h[bj].y >> 16) + a0[3];
                    const float v4 = bf2f(h[bj].z & 0xffffu) + a1[0], v5 = bf2f(h[bj].z >> 16) + a1[1], v6 = bf2f(h[bj].w & 0xffffu) + a1[2], v7 = bf2f(h[bj].w >> 16) + a1[3];
                    u32x4 w; w.x = cvtpk(v0, v1); w.y = cvtpk(v2, v3); w.z = cvtpk(v4, v5); w.w = cvtpk(v6, v7);
                    *(u32x4*)(Hout + off + bj * HALF) = w;
                    if (WITH_SS) sq += ((v0 * v0 + v1 * v1) + (v2 * v2 + v3 * v3)) + ((v4 * v4 + v5 * v5) + (v6 * v6 + v7 * v7)); }
                if (WITH_SS) { sq += __shfl_xor(sq, 16); sq += __shfl_xor(sq, 32); if (fq == 0) ss[(size_t)row * 32 + u.pn * 4 + wc] = sq; } }
    }
};
struct EpiBf16Slab {
    static constexpr bool PERM = true;
    bf16_t* O; int ldc; size_t slab;
    __device__ __forceinline__ void operator()(const f32x4 (&acc)[2][2][4][2], const Unit& u, int wr, int wc, int fr, int fq) const {
        const int row0 = u.pm * BM + wr * 64 + fr, col0 = u.pn * BM + wc * 32 + 8 * fq; bf16_t* Os = O + (size_t)u.aux * slab;
#pragma unroll
        for (int ai = 0; ai < 2; ++ai)
#pragma unroll
            for (int m = 0; m < 4; ++m) { bf16_t* rowp = Os + (size_t)(row0 + ai * HALF + m * 16) * ldc + col0;
#pragma unroll
                for (int bj = 0; bj < 2; ++bj) { const f32x4 v0 = acc[ai][bj][m][0], v1 = acc[ai][bj][m][1];
                    u32x4 w; w.x = cvtpk(v0[0], v0[1]); w.y = cvtpk(v0[2], v0[3]); w.z = cvtpk(v1[0], v1[1]); w.w = cvtpk(v1[2], v1[3]);
                    *(u32x4*)(rowp + bj * HALF) = w; } }
    }
};
struct EpiBf16SlabRS {
    static constexpr bool PERM = true;
    bf16_t* O; int ldc; size_t slab; const float* ss;
    __device__ __forceinline__ void operator()(const f32x4 (&acc)[2][2][4][2], const Unit& u, int wr, int wc, int fr, int fq) const {
        const int row0 = u.pm * BM + wr * 64 + fr, col0 = u.pn * BM + wc * 32 + 8 * fq; bf16_t* Os = O + (size_t)u.aux * slab;
#pragma unroll
        for (int ai = 0; ai < 2; ++ai)
#pragma unroll
            for (int m = 0; m < 4; ++m) { const int row = row0 + ai * HALF + m * 16; float sq = 0.f;
#pragma unroll
                for (int i = 0; i < 8; ++i) { const f32x4 p = *(const f32x4*)(ss + (size_t)row * 32 + 4 * i); sq += (p[0] + p[1]) + (p[2] + p[3]); }
                const float rs = 1.0f / sqrtf(sq * (1.0f / DM) + EPS); bf16_t* rowp = Os + (size_t)row * ldc + col0;
#pragma unroll
                for (int bj = 0; bj < 2; ++bj) { const f32x4 v0 = acc[ai][bj][m][0] * rs, v1 = acc[ai][bj][m][1] * rs;
                    u32x4 w; w.x = cvtpk(v0[0], v0[1]); w.y = cvtpk(v0[2], v0[3]); w.z = cvtpk(v1[0], v1[1]); w.w = cvtpk(v1[2], v1[3]);
                    *(u32x4*)(rowp + bj * HALF) = w; } }
    }
};
__device__ __forceinline__ float silu_mul(float g, float u) { return g * u * __builtin_amdgcn_rcpf(1.0f + __expf(-g)); }
struct EpiSwiGLU {
    static constexpr bool PERM = true;
    bf16_t* Hm; const float* rs; const float* gate;
    __device__ __forceinline__ void operator()(const f32x4 (&acc)[2][2][4][2], const Unit& u, int wr, int wc, int fr, int fq) const {
        const int row0 = u.pm * BM + wr * 64 + fr, col0 = u.pn * HALF + wc * 32 + 8 * fq;
#pragma unroll
        for (int ai = 0; ai < 2; ++ai)
#pragma unroll
            for (int m = 0; m < 4; ++m) { const int row = row0 + ai * HALF + m * 16; const float r = rs[row], gt = gate[row]; bf16_t* rowp = Hm + (size_t)row * FF + col0;
                const f32x4 g0 = acc[ai][0][m][0] * r, g1 = acc[ai][0][m][1] * r, u0 = acc[ai][1][m][0] * r, u1 = acc[ai][1][m][1] * r;
                u32x4 w; w.x = cvtpk(silu_mul(g0[0], u0[0]) * gt, silu_mul(g0[1], u0[1]) * gt); w.y = cvtpk(silu_mul(g0[2], u0[2]) * gt, silu_mul(g0[3], u0[3]) * gt);
                w.z = cvtpk(silu_mul(g1[0], u1[0]) * gt, silu_mul(g1[1], u1[1]) * gt); w.w = cvtpk(silu_mul(g1[2], u1[2]) * gt, silu_mul(g1[3], u1[3]) * gt);
                *(u32x4*)rowp = w; }
    }
};
struct EpiGate {
    static constexpr bool PERM = true;
    bf16_t* Y; const float* gate;
    __device__ __forceinline__ void operator()(const f32x4 (&acc)[2][2][4][2], const Unit& u, int wr, int wc, int fr, int fq) const {
        const int row0 = u.pm * BM + wr * 64 + fr, col0 = u.pn * BM + wc * 32 + 8 * fq;
#pragma unroll
        for (int ai = 0; ai < 2; ++ai)
#pragma unroll
            for (int m = 0; m < 4; ++m) { const int row = row0 + ai * HALF + m * 16; const float gs = gate[row]; bf16_t* rowp = Y + (size_t)row * DM + col0;
#pragma unroll
                for (int bj = 0; bj < 2; ++bj) { const f32x4 v0 = acc[ai][bj][m][0] * gs, v1 = acc[ai][bj][m][1] * gs;
                    u32x4 w; w.x = cvtpk(v0[0], v0[1]); w.y = cvtpk(v0[2], v0[3]); w.z = cvtpk(v1[0], v1[1]); w.w = cvtpk(v1[2], v1[3]);
                    *(u32x4*)(rowp + bj * HALF) = w; } }
    }
};

template <class Epi, class Sched, bool ALIGN_EPI = true, bool SP2 = true>
__device__ __forceinline__ void gemm_phase(LAS unsigned char* lds, const int tid_in, const int K, const int lda, const int ldb, const Sched& S, const Epi& E) {
    const int tid = opq_v(tid_in);
    const int wid = __builtin_amdgcn_readfirstlane(tid >> 6), lane = tid & 63, wr = wid >> 2, wc = wid & 3, fr = lane & 15, fq = lane >> 4;
    const int nt = K / BK;
    unsigned voffB[2];
#pragma unroll
    for (int i = 0; i < 2; ++i) { int R, C; stage_rc(tid * 16 + i * 8192, R, C); const int Rb = Epi::PERM ? ((R & ~31) + perm32(R & 31)) : R;
        voffB[i] = (unsigned)(Rb * ldb + C) * 2u; }
    const size_t kstep = (size_t)(BK * 2);
    const size_t hstepB = (size_t)HALF * ldb * 2;
    unsigned cvA[2][2], nvA[2][2];
#define PG8_FILLA(dst, unit) do { _Pragma("unroll") for (int _h = 0; _h < 2; ++_h) _Pragma("unroll") for (int _i = 0; _i < 2; ++_i) { int _R, _C; stage_rc(tid * 16 + _i * 8192, _R, _C); \
        if constexpr (Sched::GATHER) dst[_h][_i] = (unsigned)S.rows[(unit).pm * BM + _h * HALF + _R] * (unsigned)(lda * 2) + (unsigned)(_C * 2); \
        else dst[_h][_i] = (unsigned)((_h * HALF + _R) * lda + _C) * 2u; } } while (0)
    const unsigned ldsw = (unsigned)wid * 1024u;
    const int aoff = lds_byte(wr * 64 + fr, fq * 8), boff = lds_byte(wc * 32 + fr, fq * 8);
#define PG8_SA(b, h) (((b) * 2 + (h)) * HTB)
#define PG8_SB(b, h) ((4 + (b) * 2 + (h)) * HTB)
#define PG8_STAGE(bufoff, gbase, voff) do { _Pragma("unroll") for (int _i = 0; _i < 2; ++_i) \
        __builtin_amdgcn_global_load_lds((const unsigned*)((const char*)(gbase) + (voff)[_i]), (LAS unsigned*)(lds + (bufoff) + ldsw + _i * 8192), 16, 0, 0); } while (0)
#define PG8_LDA(dst, b, h) do { _Pragma("unroll") for (int m = 0; m < 4; ++m) _Pragma("unroll") for (int k = 0; k < 2; ++k) dst[m][k] = *(const LAS bf16x8*)(lds + PG8_SA(b, h) + aoff + m * 2048 + k * 1024); } while (0)
#define PG8_LDB(dst, b, h) do { _Pragma("unroll") for (int n = 0; n < 2; ++n) _Pragma("unroll") for (int k = 0; k < 2; ++k) dst[n][k] = *(const LAS bf16x8*)(lds + PG8_SB(b, h) + boff + n * 2048 + k * 1024); } while (0)
#define PG8_MMA(ai, bj, At, Bt) do { __builtin_amdgcn_s_setprio(1); _Pragma("unroll") for (int m = 0; m < 4; ++m) _Pragma("unroll") for (int n = 0; n < 2; ++n) _Pragma("unroll") for (int k = 0; k < 2; ++k) \
        acc[ai][bj][m][n] = __builtin_amdgcn_mfma_f32_16x16x32_bf16(Bt[n][k], At[m][k], acc[ai][bj][m][n], 0, 0, 0); __builtin_amdgcn_s_setprio(0); } while (0)
#define PG8_WAIT_V(n) asm volatile("s_waitcnt vmcnt(" #n ")" ::: "memory")
#define PG8_WAIT_L(n) asm volatile("s_waitcnt lgkmcnt(" #n ")" ::: "memory")
#define PG8_BAR __builtin_amdgcn_s_barrier()
#define PG8_SCHED __builtin_amdgcn_sched_barrier(0)
    Unit cur, nxt; int ui = 0;
    if (!S.next(0, cur)) return;
    f32x4 acc[2][2][4][2];
#pragma unroll
    for (int a = 0; a < 2; ++a)
#pragma unroll
        for (int b = 0; b < 2; ++b)
#pragma unroll
            for (int m = 0; m < 4; ++m)
#pragma unroll
                for (int n = 0; n < 2; ++n) acc[a][b][m][n] = (f32x4){0.f, 0.f, 0.f, 0.f};
    bf16x8 At[4][2], B0[2][2], B1[2][2];
    const char* cA = cur.a; const char* cB = cur.b;
    PG8_FILLA(cvA, cur);
    if constexpr (Sched::GATHER) asm volatile("s_waitcnt vmcnt(0)" ::: "memory");
    if constexpr (SP2) {
        PG8_STAGE(PG8_SB(0, 0), cB, voffB); PG8_STAGE(PG8_SB(0, 1), cB + hstepB, voffB); PG8_STAGE(PG8_SA(0, 0), cA, cvA[0]); PG8_STAGE(PG8_SA(0, 1), cA, cvA[1]);
        if (wr == 1) PG8_BAR;
        PG8_WAIT_V(2); PG8_BAR;
        PG8_STAGE(PG8_SB(1, 0), cB + kstep, voffB); PG8_STAGE(PG8_SA(1, 0), cA + kstep, cvA[0]); PG8_STAGE(PG8_SB(1, 1), cB + hstepB + kstep, voffB);
        PG8_WAIT_V(6); PG8_BAR;
    } else {
        PG8_STAGE(PG8_SB(0, 0), cB, voffB); PG8_STAGE(PG8_SA(0, 0), cA, cvA[0]); PG8_STAGE(PG8_SB(0, 1), cB + hstepB, voffB); PG8_STAGE(PG8_SA(0, 1), cA, cvA[1]);
        if (wr == 1) PG8_BAR;
        PG8_WAIT_V(4); PG8_BAR;
        PG8_STAGE(PG8_SB(1, 0), cB + kstep, voffB); PG8_STAGE(PG8_SA(1, 0), cA + kstep, cvA[0]); PG8_STAGE(PG8_SB(1, 1), cB + hstepB + kstep, voffB);
        PG8_WAIT_V(6); PG8_BAR;
    }
    for (;;) {
        const bool has_next = S.next(ui + 1, nxt);
        const char* nA = has_next ? nxt.a : cA; const char* nB = has_next ? nxt.b : cB;
        if constexpr (Sched::GATHER) {
            if (has_next) { PG8_FILLA(nvA, nxt); asm volatile("s_waitcnt vmcnt(0)" ::: "memory"); }
            else {
#pragma unroll
                for (int _h = 0; _h < 2; ++_h)
#pragma unroll
                    for (int _i = 0; _i < 2; ++_i) nvA[_h][_i] = cvA[_h][_i]; }
        }
        for (int t = 0; t < nt; t += 2) {
            const bool last = (t == nt - 2);
            const char* a1 = cA + (size_t)(t + 1) * kstep;
            const char* a2 = last ? nA : cA + (size_t)(t + 2) * kstep; const char* b2 = last ? nB : cB + (size_t)(t + 2) * kstep;
            const char* a3 = a2 + kstep; const char* b3 = b2 + kstep;
            unsigned xa0[2], xa1[2];
            if constexpr (Sched::GATHER) {
#pragma unroll
                for (int _i = 0; _i < 2; ++_i) { xa0[_i] = last ? nvA[0][_i] : cvA[0][_i]; xa1[_i] = last ? nvA[1][_i] : cvA[1][_i]; }
            } else {
#pragma unroll
                for (int _i = 0; _i < 2; ++_i) { xa0[_i] = cvA[0][_i]; xa1[_i] = cvA[1][_i]; }
            }
            if constexpr (SP2) {
            PG8_LDB(B0, 0, 0); PG8_LDB(B1, 0, 1); PG8_SCHED; PG8_LDA(At, 0, 0); PG8_STAGE(PG8_SA(1, 1), a1, cvA[1]);
            PG8_WAIT_V(8); PG8_WAIT_L(0); PG8_BAR; PG8_MMA(0, 0, At, B0); PG8_MMA(0, 1, At, B1); PG8_BAR; PG8_SCHED;
            PG8_LDA(At, 0, 1); PG8_STAGE(PG8_SB(0, 0), b2, voffB); PG8_STAGE(PG8_SB(0, 1), b2 + hstepB, voffB); PG8_STAGE(PG8_SA(0, 0), a2, xa0);
            PG8_WAIT_V(8); PG8_WAIT_L(0); PG8_BAR; PG8_MMA(1, 0, At, B0); PG8_MMA(1, 1, At, B1); PG8_BAR; PG8_SCHED;
            PG8_LDB(B0, 1, 0); PG8_LDB(B1, 1, 1); PG8_SCHED; PG8_LDA(At, 1, 0); PG8_STAGE(PG8_SA(0, 1), a2, xa1);
            PG8_WAIT_V(8); PG8_WAIT_L(0); PG8_BAR; PG8_MMA(0, 0, At, B0); PG8_MMA(0, 1, At, B1); PG8_BAR; PG8_SCHED;
            PG8_LDA(At, 1, 1); PG8_STAGE(PG8_SB(1, 0), b3, voffB); PG8_STAGE(PG8_SB(1, 1), b3 + hstepB, voffB); PG8_STAGE(PG8_SA(1, 0), a3, xa0);
            PG8_WAIT_V(8); PG8_WAIT_L(0); PG8_BAR; PG8_MMA(1, 0, At, B0); PG8_MMA(1, 1, At, B1); PG8_BAR; PG8_SCHED;
            } else {
            PG8_LDB(B0, 0, 0); PG8_SCHED; PG8_LDA(At, 0, 0); PG8_STAGE(PG8_SA(1, 1), a1, cvA[1]);
            PG8_WAIT_L(8); PG8_BAR; PG8_WAIT_L(0); PG8_MMA(0, 0, At, B0); PG8_BAR; PG8_SCHED;
            PG8_LDB(B1, 0, 1); PG8_STAGE(PG8_SB(0, 0), b2, voffB);
            PG8_BAR; PG8_WAIT_L(0); PG8_MMA(0, 1, At, B1); PG8_BAR;
            PG8_LDA(At, 0, 1); PG8_STAGE(PG8_SA(0, 0), a2, xa0);
            PG8_BAR; PG8_WAIT_L(0); PG8_MMA(1, 0, At, B0); PG8_BAR; PG8_SCHED;
            PG8_STAGE(PG8_SB(0, 1), b2 + hstepB, voffB);
            PG8_WAIT_V(6); PG8_BAR; PG8_MMA(1, 1, At, B1); PG8_BAR;
            PG8_LDB(B0, 1, 0); PG8_SCHED; PG8_LDA(At, 1, 0); PG8_STAGE(PG8_SA(0, 1), a2, xa1);
            PG8_WAIT_L(8); PG8_BAR; PG8_WAIT_L(0); PG8_MMA(0, 0, At, B0); PG8_BAR; PG8_SCHED;
            PG8_LDB(B1, 1, 1); PG8_STAGE(PG8_SB(1, 0), b3, voffB);
            PG8_BAR; PG8_WAIT_L(0); PG8_MMA(0, 1, At, B1); PG8_BAR;
            PG8_LDA(At, 1, 1); PG8_STAGE(PG8_SA(1, 0), a3, xa0);
            PG8_BAR; PG8_WAIT_L(0); PG8_MMA(1, 0, At, B0); PG8_BAR; PG8_SCHED;
            PG8_STAGE(PG8_SB(1, 1), b3 + hstepB, voffB);
            PG8_WAIT_V(6); PG8_BAR; PG8_MMA(1, 1, At, B1); PG8_BAR;
            }
        }
        if constexpr (ALIGN_EPI) { if (wr == 0) PG8_BAR; }
        E(acc, cur, wr, wc, fr, fq);
        if (!has_next) break;
#pragma unroll
        for (int a = 0; a < 2; ++a)
#pragma unroll
            for (int b = 0; b < 2; ++b)
#pragma unroll
                for (int m = 0; m < 4; ++m)
#pragma unroll
                    for (int n = 0; n < 2; ++n) acc[a][b][m][n] = (f32x4){0.f, 0.f, 0.f, 0.f};
        cur = nxt; cA = nA; cB = nB; ++ui;
        if constexpr (Sched::GATHER) {
#pragma unroll
            for (int _h = 0; _h < 2; ++_h)
#pragma unroll
                for (int _i = 0; _i < 2; ++_i) cvA[_h][_i] = nvA[_h][_i]; }
        if constexpr (ALIGN_EPI) { if (wr == 1) PG8_BAR; }
    }
    PG8_WAIT_V(0);
    if constexpr (!ALIGN_EPI) { if (wr == 0) PG8_BAR; }
    PG8_BAR;
#undef PG8_FILLA
#undef PG8_SA
#undef PG8_SB
#undef PG8_STAGE
#undef PG8_LDA
#undef PG8_LDB
#undef PG8_MMA
#undef PG8_WAIT_V
#undef PG8_WAIT_L
#undef PG8_BAR
#undef PG8_SCHED
}
}


namespace bgw {
constexpr int IPL = 48 * 1024;
struct Item { const float* src; const float* gk; bf16_t* dst; int N, K, k0, n0, drow0; };
struct NoWork { static constexpr bool DEPTH2 = false; __device__ __forceinline__ void step_a(int) {} __device__ __forceinline__ void step_b(int) {} };
struct Work {
    static constexpr bool DEPTH2 = true;
    int cur, end, iss, kind, pend0, pend1;
    unsigned char* ws; volatile LAS unsigned long long* ptab; LAS float* scr;
    f32x4 a0, a1, a2, a3, b0, b1, b2, b3;
    __device__ __forceinline__ Item decode(int idx) const {
        const int id = kind == 1 ? 2 * 16384 + idx : (kind == 3 ? 3 * IPL + 2 * 16384 + idx : (idx < IPL ? IPL + idx : 2 * IPL + 2 * 16384 + (kind == 4 ? 8192 : 0) + (idx - IPL)));
        const int l = id / IPL, rr = id % IPL, fam = rr >> 14, mat = l * 16 + ((rr >> 10) & 15), it = rr & 1023; Item t;
        if (fam < 2) { t.n0 = (it & 31) * 32; t.k0 = 64 * (it >> 5); t.src = ldp(ptab, 26 + fam) + (size_t)mat * 2048 * 1024; t.N = 1024; t.dst = (bf16_t*)(ws + W_M1) + (size_t)mat * 2048 * 2048; t.K = 2048;
            t.drow0 = (t.n0 >> 7) * 256 + (t.n0 & 127) + (fam == 1 ? 128 : 0); t.gk = ldp(ptab, 4) + l * DM; }
        else { t.n0 = (it & 63) * 32; t.k0 = 64 * (it >> 6); t.src = ldp(ptab, 28) + (size_t)mat * 1024 * 2048; t.N = 2048; t.dst = (bf16_t*)(ws + W_M2) + (size_t)mat * 2048 * 1024; t.K = 1024; t.drow0 = t.n0; t.gk = nullptr; }
        return t;
    }
    template <int P> __device__ __forceinline__ void step_a(int lane) {
        if (iss >= end) return;
        const Item t = decode(iss); const int krow = lane >> 3, n4 = lane & 7;
        const float* p = t.src + (size_t)(t.k0 + 32 * P + krow) * t.N + t.n0 + 4 * n4; const size_t st = (size_t)8 * t.N;
        if (P == 0) { pend0 = 1; a0 = __builtin_nontemporal_load((const f32x4*)p); a1 = __builtin_nontemporal_load((const f32x4*)(p + st)); a2 = __builtin_nontemporal_load((const f32x4*)(p + 2 * st)); a3 = __builtin_nontemporal_load((const f32x4*)(p + 3 * st)); }
        else { pend1 = 1; b0 = __builtin_nontemporal_load((const f32x4*)p); b1 = __builtin_nontemporal_load((const f32x4*)(p + st)); b2 = __builtin_nontemporal_load((const f32x4*)(p + 2 * st)); b3 = __builtin_nontemporal_load((const f32x4*)(p + 3 * st)); iss = iss + 1; }
    }
    template <int P> __device__ __forceinline__ void step_b(int lane) {
        if (!(P == 0 ? pend0 : pend1)) return;
        if (P == 0) pend0 = 0; else pend1 = 0;
        const int krow = lane >> 3, n4 = lane & 7;
        const f32x4 r0 = P == 0 ? a0 : b0, r1 = P == 0 ? a1 : b1, r2 = P == 0 ? a2 : b2, r3 = P == 0 ? a3 : b3;
        { LAS float* p = scr + (32 * P + krow) * 33 + 4 * n4;
          p[0] = r0.x; p[1] = r0.y; p[2] = r0.z; p[3] = r0.w; p[8 * 33 + 0] = r1.x; p[8 * 33 + 1] = r1.y; p[8 * 33 + 2] = r1.z; p[8 * 33 + 3] = r1.w;
          p[16 * 33 + 0] = r2.x; p[16 * 33 + 1] = r2.y; p[16 * 33 + 2] = r2.z; p[16 * 33 + 3] = r2.w; p[24 * 33 + 0] = r3.x; p[24 * 33 + 1] = r3.y; p[24 * 33 + 2] = r3.z; p[24 * 33 + 3] = r3.w; }
        if (P == 1) { const Item t = decode(cur); const int c = lane & 7;
            f32x4 g0 = {1.f, 1.f, 1.f, 1.f}, g1 = {1.f, 1.f, 1.f, 1.f}; if (t.gk) { g0 = *(const f32x4*)(t.gk + t.k0 + 8 * c); g1 = *(const f32x4*)(t.gk + t.k0 + 8 * c + 4); }
#pragma unroll
            for (int j = 0; j < 4; ++j) { const int n = (lane >> 3) + 8 * j; const LAS float* s = scr + (8 * c) * 33 + n;
                u32x4 o; o.x = cvtpk(s[0 * 33] * g0[0], s[1 * 33] * g0[1]); o.y = cvtpk(s[2 * 33] * g0[2], s[3 * 33] * g0[3]); o.z = cvtpk(s[4 * 33] * g1[0], s[5 * 33] * g1[1]); o.w = cvtpk(s[6 * 33] * g1[2], s[7 * 33] * g1[3]);
                __builtin_nontemporal_store(o, (u32x4*)(t.dst + (size_t)(t.drow0 + n) * t.K + t.k0 + 8 * c)); }
            cur = cur + 1; }
    }
};
}

namespace att {
constexpr int NW = 8, QBLK = 32, KVBLK = 64;
constexpr float THR = 8.f;
#define SBAR() __builtin_amdgcn_sched_barrier(0)
__device__ __forceinline__ int crow(int r, int hi) { return (r & 3) + 8 * (r >> 2) + 4 * hi; }

__device__ __forceinline__ void partialSM(f32x16& p0, f32x16& p1, float& m_reg, float& mn, float& alpha, const float C, const float thr_raw) {
  float pmax = p0[0];
#pragma unroll
  for (int r = 1; r < 16; ++r) pmax = fmaxf(pmax, p0[r]);
#pragma unroll
  for (int r = 0; r < 16; ++r) pmax = fmaxf(pmax, p1[r]);
  { auto rr = __builtin_amdgcn_permlane32_swap(__float_as_uint(pmax), __float_as_uint(pmax), false, false);
    pmax = fmaxf(__uint_as_float(rr[0]), __uint_as_float(rr[1])); }
  if (__builtin_expect(__all(pmax - m_reg <= thr_raw), 1)) { mn = m_reg; alpha = 1.f; }
  else { mn = fmaxf(m_reg, pmax); alpha = __builtin_amdgcn_exp2f((m_reg - mn) * C); m_reg = mn; }
  const float mnC = -mn * C;
#pragma unroll
  for (int r = 0; r < 16; ++r) p0[r] = fmaf(p0[r], C, mnC);
#pragma unroll
  for (int r = 0; r < 16; ++r) p1[r] = fmaf(p1[r], C, mnC);
#pragma unroll
  for (int r = 0; r < 16; ++r) p0[r] = __builtin_amdgcn_exp2f(p0[r]);
}
__device__ __forceinline__ void finishSM(f32x16& p0, f32x16& p1, float alpha, float& l_reg, bf16x8& pa0, bf16x8& pa1, bf16x8& pa2, bf16x8& pa3) {
#pragma unroll
  for (int r = 0; r < 16; ++r) p1[r] = __builtin_amdgcn_exp2f(p1[r]);
  float ps = 0;
#pragma unroll
  for (int r = 0; r < 16; ++r) ps += p0[r];
#pragma unroll
  for (int r = 0; r < 16; ++r) ps += p1[r];
  { auto rr = __builtin_amdgcn_permlane32_swap(__float_as_uint(ps), __float_as_uint(ps), false, false);
    ps = __uint_as_float(rr[0]) + __uint_as_float(rr[1]); }
  l_reg = l_reg * alpha + ps;
#define PK4(P, BASE, OUT) do { unsigned a0 = cvtpk(P[BASE + 0], P[BASE + 1]), a1 = cvtpk(P[BASE + 2], P[BASE + 3]);   \
    unsigned b0 = cvtpk(P[BASE + 4], P[BASE + 5]), b1 = cvtpk(P[BASE + 6], P[BASE + 7]);                              \
    auto r0 = __builtin_amdgcn_permlane32_swap(a0, b0, false, false); auto r1 = __builtin_amdgcn_permlane32_swap(a1, b1, false, false); \
    u32x4 w = {r0[0], r1[0], r0[1], r1[1]}; OUT = *reinterpret_cast<bf16x8*>(&w); } while (0)
  PK4(p0, 0, pa0); PK4(p0, 8, pa1); PK4(p1, 0, pa2); PK4(p1, 8, pa3);
#undef PK4
}
template <int DK> __device__ __forceinline__ int kswz(int row, int colB) { return row * (DK * 2 + 16) + colB; }
template <int DK>
__device__ __forceinline__ void qkt(f32x16& p0, f32x16& p1, const char* Ks, const bf16x8* qr, int r32, int hi) {
  p0 = f32x16{}; p1 = f32x16{};
#pragma unroll
  for (int d0 = 0; d0 < DK / 16; ++d0) { const int cb = (d0 * 16 + hi * 8) * 2;
    const bf16x8 b0 = *reinterpret_cast<const bf16x8*>(Ks + kswz<DK>(r32, cb));
    const bf16x8 b1 = *reinterpret_cast<const bf16x8*>(Ks + kswz<DK>(32 + r32, cb));
    p0 = __builtin_amdgcn_mfma_f32_32x32x16_bf16(b0, qr[d0], p0, 0, 0, 0);
    p1 = __builtin_amdgcn_mfma_f32_32x32x16_bf16(b1, qr[d0], p1, 0, 0, 0); }
}
__device__ __forceinline__ int v_st(int k, int c) { const int kk = (k & ~0xC) | ((k & 4) << 1) | ((k & 8) >> 1); return ((kk >> 3) * 4 + (c >> 5)) * 512 + ((kk & 7) * 32 + (c & 31)) * 2; }
__device__ __forceinline__ int v_rd_base(int lane) { return ((lane & 3) << 3) | (((lane >> 2) & 3) << 6) | (((lane >> 4) & 1) << 5) | (((lane >> 5) & 1) << 8); }
constexpr int v_rd_off(int d0, int ks, int half) { return d0 * 512 + ks * 4096 + half * 2048; }
template <int OFF> __device__ __forceinline__ s16x4 tr_read(int vb) {
  s16x4 r; asm volatile("ds_read_b64_tr_b16 %0, %1 offset:%2" : "=&v"(r) : "v"(vb), "i"(OFF) : "memory"); return r;
}
template <int D0> __device__ __forceinline__ void pv_one(f32x16& od, int vb, bf16x8 pa0, bf16x8 pa1, bf16x8 pa2, bf16x8 pa3) {
  const s16x4 l0 = tr_read<v_rd_off(D0, 0, 0)>(vb), h0 = tr_read<v_rd_off(D0, 0, 1)>(vb), l1 = tr_read<v_rd_off(D0, 1, 0)>(vb), h1 = tr_read<v_rd_off(D0, 1, 1)>(vb);
  const s16x4 l2 = tr_read<v_rd_off(D0, 2, 0)>(vb), h2 = tr_read<v_rd_off(D0, 2, 1)>(vb), l3 = tr_read<v_rd_off(D0, 3, 0)>(vb), h3 = tr_read<v_rd_off(D0, 3, 1)>(vb);
  asm volatile("s_waitcnt lgkmcnt(0)" ::: "memory"); SBAR();
#define PK(L, H) (bf16x8){L[0], L[1], L[2], L[3], H[0], H[1], H[2], H[3]}
  od = __builtin_amdgcn_mfma_f32_32x32x16_bf16(pa0, PK(l0, h0), od, 0, 0, 0);
  od = __builtin_amdgcn_mfma_f32_32x32x16_bf16(pa1, PK(l1, h1), od, 0, 0, 0);
  od = __builtin_amdgcn_mfma_f32_32x32x16_bf16(pa2, PK(l2, h2), od, 0, 0, 0);
  od = __builtin_amdgcn_mfma_f32_32x32x16_bf16(pa3, PK(l3, h3), od, 0, 0, 0);
#undef PK
}
__device__ __forceinline__ void pv_d0(f32x16* o, int vb, bf16x8 pa0, bf16x8 pa1, bf16x8 pa2, bf16x8 pa3) {
  pv_one<0>(o[0], vb, pa0, pa1, pa2, pa3); pv_one<1>(o[1], vb, pa0, pa1, pa2, pa3); pv_one<2>(o[2], vb, pa0, pa1, pa2, pa3); pv_one<3>(o[3], vb, pa0, pa1, pa2, pa3);
}

template <int DK, class F, class BG>
__device__ __forceinline__ void attn_unit(const F& f, char* lds, const int tid_in, BG& bg) {
  constexpr int SHM_V = KVBLK * 128 * 2, SHM_K = KVBLK * (DK * 2 + 16), KP = DK / 64, KPR = DK / 8;
  const int tid = opq_v(tid_in);
  const int wid = tid >> 6, lane = tid & 63, r32 = lane & 31, hi = lane >> 5;
  char* V_lds = lds; char* K_lds = lds + 2 * SHM_V;
  float* ws = (float*)(lds + 2 * SHM_V + 2 * SHM_K) + wid * 64; float* li_l = ws; float* al_l = ws + 32;
  const int myrow = wid * QBLK + r32;
  float m_reg = f.m_init(myrow), l_reg = f.l_init(); f32x16 o[4] = {}; bf16x8 qr[DK / 16];
  const bf16_t* Qw = f.qptr(myrow) + hi * 8;
#pragma unroll
  for (int d0 = 0; d0 < DK / 16; ++d0) qr[d0] = f.loadq(Qw + d0 * 16);
  f.template fixq<DK / 16>(qr, myrow, hi);
  const int wid_u = __builtin_amdgcn_readfirstlane(wid);
  const int sr = tid >> 4, sc = (tid & 15) * 8, vst0 = v_st(sr, sc), vst1 = v_st(32 + sr, sc);
  unsigned kvo[KP]; int kst[KP];
#pragma unroll
  for (int q = 0; q < KP; ++q) { const int p = tid + 512 * q, krw = p / KPR, kcl = (p % KPR) * 8; kvo[q] = (unsigned)(krw * f.ldk + kcl) * 2u; kst[q] = kswz<DK>(krw, kcl * 2); }
  const unsigned vvo0 = (unsigned)(sr * f.ldv + sc) * 2u, vvo1 = vvo0 + (unsigned)(64 * f.ldv);
  const int vb0 = (int)(uintptr_t)V_lds + v_rd_base(lane);
  const float C = f.C, thr_raw = f.thr_raw; const int NT = f.NT;
  bf16x8 vs0, vs1, ks[KP];
#define SLOAD(jt) do { const long _k0 = f.key0(jt); const char* _vb = (const char*)f.Vb + _k0 * (f.ldv * 2); const char* _kb = (const char*)f.Kb + _k0 * (f.ldk * 2); \
    vs0 = *(const bf16x8*)(_vb + vvo0); vs1 = *(const bf16x8*)(_vb + vvo1); \
    _Pragma("unroll") for (int _q = 0; _q < KP; ++_q) ks[_q] = *(const bf16x8*)(_kb + kvo[_q]); } while (0)
#define SWRITE(b) do { *(bf16x8*)(V_lds + (b) * SHM_V + vst0) = vs0; *(bf16x8*)(V_lds + (b) * SHM_V + vst1) = vs1; \
    _Pragma("unroll") for (int _q = 0; _q < KP; ++_q) *(bf16x8*)(K_lds + (b) * SHM_K + kst[_q]) = ks[_q]; } while (0)
  SLOAD(0); SWRITE(0); if (NT > 1) SLOAD(1);
  __syncthreads();
#define ATT_TILE(j, b, BGSTEP) do { \
    f32x16 p0, p1; bf16x8 pa0, pa1, pa2, pa3; float mn, alpha; \
    const bool sk = f.skip(j, wid_u);                                    \
    if (!sk) qkt<DK>(p0, p1, K_lds + (b) * SHM_K, qr, r32, hi); \
    if ((j) + 1 < NT) { SWRITE((b) ^ 1); if ((j) + 2 < NT) SLOAD((j) + 2); } \
    BGSTEP;     \
    if (!sk) { \
    f.apply(p0, p1, j, myrow, hi); \
    partialSM(p0, p1, m_reg, mn, alpha, C, thr_raw); \
    if (__any(alpha < 1.f)) { if (hi == 0) al_l[r32] = alpha; asm volatile("s_waitcnt lgkmcnt(0)" ::: "memory"); \
      _Pragma("unroll") for (int d = 0; d < 4; ++d) _Pragma("unroll") for (int r = 0; r < 16; ++r) o[d][r] *= al_l[crow(r, hi)]; } \
    finishSM(p0, p1, alpha, l_reg, pa0, pa1, pa2, pa3); SBAR(); \
    pv_d0(o, vb0 + (b) * SHM_V, pa0, pa1, pa2, pa3); \
    } \
    __syncthreads(); } while (0)
  if constexpr (BG::DEPTH2) {
#pragma unroll 1
    for (int j = 0; j < NT; j += 2) { ATT_TILE(j, 0, (bg.template step_b<0>(lane), bg.template step_a<0>(lane))); ATT_TILE(j + 1, 1, (bg.template step_b<1>(lane), bg.template step_a<1>(lane))); }
  } else {
#pragma unroll 1
    for (int j = 0; j < NT; ++j) { const int b = j & 1; ATT_TILE(j, b, (bg.step_b(lane), bg.step_a(lane))); }
  }
#undef ATT_TILE
  if (hi == 0) li_l[r32] = l_reg; asm volatile("s_waitcnt lgkmcnt(0)" ::: "memory");
  const int orow0 = opq_v(wid * QBLK + 4 * hi);
  float rli[16];
#pragma unroll
  for (int r = 0; r < 16; ++r) rli[r] = __builtin_amdgcn_rcpf(li_l[crow(r, hi)]);
#pragma unroll
  for (int r = 0; r < 16; ++r) { bf16_t* op = f.optr(orow0 + (r & 3) + 8 * (r >> 2)) + r32;
#pragma unroll
    for (int d0 = 0; d0 < 4; ++d0) op[d0 * 32] = f2bf(o[d0][r] * rli[r]); }
#undef SLOAD
#undef SWRITE
}
template <int DK, class F>
__device__ __forceinline__ void attn_unit2(const F& f, char* lds, const int tid) {
  constexpr int SHM_V = KVBLK * 128 * 2, SHM_K = KVBLK * (DK * 2 + 16), KP = DK / 64, KPR = DK / 8;
  const int wid = tid >> 6, lane = tid & 63, r32 = lane & 31, hi = lane >> 5;
  char* V_lds = lds; char* K_lds = lds + 2 * SHM_V;
  float* ws = (float*)(lds + 2 * SHM_V + 2 * SHM_K) + wid * 64; float* li_l = ws; float* al_l = ws + 32;
  const int myrow = wid * QBLK + r32;
  float m_reg = f.m_init(myrow), l_reg = f.l_init(); f32x16 o[4] = {}; bf16x8 qr[DK / 16];
  const bf16_t* Qw = f.qptr(myrow) + hi * 8;
#pragma unroll
  for (int d0 = 0; d0 < DK / 16; ++d0) qr[d0] = *reinterpret_cast<const bf16x8*>(Qw + d0 * 16);
  const int sr = tid >> 4, sc = (tid & 15) * 8, vst0 = v_st(sr, sc), vst1 = v_st(32 + sr, sc);
  unsigned kvo[KP]; int kst[KP];
#pragma unroll
  for (int q = 0; q < KP; ++q) { const int p = tid + 512 * q, krw = p / KPR, kcl = (p % KPR) * 8; kvo[q] = (unsigned)(krw * f.ldk + kcl) * 2u; kst[q] = kswz<DK>(krw, kcl * 2); }
  const unsigned vvo0 = (unsigned)(sr * f.ldv + sc) * 2u, vvo1 = vvo0 + (unsigned)(64 * f.ldv);
  const int vb0 = (int)(uintptr_t)V_lds + v_rd_base(lane);
  const float C = f.C, thr_raw = f.thr_raw; const int NT = f.NT;
  struct { bf16x8 vs0, vs1, ks[KP]; } sr_[1];
#define SLOAD(i, jt) do { const long _k0 = f.key0(jt); const char* _vb = (const char*)f.Vb + _k0 * (f.ldv * 2); const char* _kb = (const char*)f.Kb + _k0 * (f.ldk * 2); \
    sr_[i].vs0 = *(const bf16x8*)(_vb + vvo0); sr_[i].vs1 = *(const bf16x8*)(_vb + vvo1); \
    _Pragma("unroll") for (int _q = 0; _q < KP; ++_q) sr_[i].ks[_q] = *(const bf16x8*)(_kb + kvo[_q]); } while (0)
#define SWRITE(b, i) do { *(bf16x8*)(V_lds + (b) * SHM_V + vst0) = sr_[i].vs0; *(bf16x8*)(V_lds + (b) * SHM_V + vst1) = sr_[i].vs1; \
    _Pragma("unroll") for (int _q = 0; _q < KP; ++_q) *(bf16x8*)(K_lds + (b) * SHM_K + kst[_q]) = sr_[i].ks[_q]; } while (0)
#define SWAIT() asm volatile("s_waitcnt vmcnt(0)" ::: "memory")
#define RESC(a) do { if (__any((a) < 1.f)) { if (hi == 0) al_l[r32] = (a); asm volatile("s_waitcnt lgkmcnt(0)" ::: "memory"); \
    _Pragma("unroll") for (int d = 0; d < 4; ++d) _Pragma("unroll") for (int r = 0; r < 16; ++r) o[d][r] *= al_l[crow(r, hi)]; } } while (0)
#define PSM(P0, P1, MN, AL, jt) do { f.apply(P0, P1, (jt), myrow, hi); partialSM(P0, P1, m_reg, MN, AL, C, thr_raw); } while (0)
  f32x16 pA0, pA1, pB0, pB1; float mnA, mnB, alA, alB; bf16x8 pa0, pa1, pa2, pa3;
  constexpr int SE = 0, SO = 0;
  SLOAD(SE, 0); asm volatile("s_waitcnt vmcnt(0)" ::: "memory"); SWRITE(0, SE); __syncthreads();
  qkt<DK>(pA0, pA1, K_lds, qr, r32, hi); PSM(pA0, pA1, mnA, alA, 0);
  SLOAD(SO, 1);
  SWAIT(); SWRITE(1, SO); __syncthreads();
#pragma unroll 1
  for (int j = 1; j + 1 < NT; j += 2) {
    SBAR(); qkt<DK>(pB0, pB1, K_lds + SHM_K, qr, r32, hi);
    finishSM(pA0, pA1, alA, l_reg, pa0, pa1, pa2, pa3); SBAR();
    SLOAD(SE, j + 1); SBAR();
    pv_d0(o, vb0, pa0, pa1, pa2, pa3); PSM(pB0, pB1, mnB, alB, j);
    __syncthreads(); SWAIT(); SWRITE(0, SE);
    RESC(alB); __syncthreads();
    SBAR(); qkt<DK>(pA0, pA1, K_lds, qr, r32, hi);
    finishSM(pB0, pB1, alB, l_reg, pa0, pa1, pa2, pa3); SBAR();
    SLOAD(SO, j + 2); SBAR();
    pv_d0(o, vb0 + (int)SHM_V, pa0, pa1, pa2, pa3); PSM(pA0, pA1, mnA, alA, j + 1);
    __syncthreads(); SWAIT(); SWRITE(1, SO);
    RESC(alA); __syncthreads();
  }
  SBAR(); qkt<DK>(pB0, pB1, K_lds + SHM_K, qr, r32, hi);
  finishSM(pA0, pA1, alA, l_reg, pa0, pa1, pa2, pa3); SBAR();
  pv_d0(o, vb0, pa0, pa1, pa2, pa3); PSM(pB0, pB1, mnB, alB, NT - 1);
  __syncthreads(); RESC(alB);
  finishSM(pB0, pB1, alB, l_reg, pa0, pa1, pa2, pa3); SBAR();
  pv_d0(o, vb0 + (int)SHM_V, pa0, pa1, pa2, pa3);
  if (hi == 0) li_l[r32] = l_reg; asm volatile("s_waitcnt lgkmcnt(0)" ::: "memory");
  const int orow0 = opq_v(wid * QBLK + 4 * hi);
  float rli[16];
#pragma unroll
  for (int r = 0; r < 16; ++r) rli[r] = __builtin_amdgcn_rcpf(li_l[crow(r, hi)]);
#pragma unroll
  for (int r = 0; r < 16; ++r) { bf16_t* op = f.optr(orow0 + (r & 3) + 8 * (r >> 2)) + r32;
#pragma unroll
    for (int d0 = 0; d0 < 4; ++d0) op[d0 * 32] = f2bf(o[d0][r] * rli[r]); }
#undef SLOAD
#undef SWRITE
#undef SWAIT
#undef RESC
#undef PSM
}
constexpr float LOG2E = 1.4426950408889634f;
constexpr float SC128 = 0.088388347648318440f, ISC128 = 11.313708498984761f;
constexpr float SC192 = 0.072168783648703220f;

struct FBase {
  const bf16_t* Kb; const bf16_t* Vb; int ldk, ldv, NT; float C, thr_raw;
  __device__ __forceinline__ float l_init() const { return 0.f; }
  __device__ __forceinline__ float m_init(int) const { return -1e30f; }
  __device__ __forceinline__ void apply(f32x16&, f32x16&, int, int, int) const {}
  __device__ __forceinline__ bf16x8 loadq(const bf16_t* p) const { return *reinterpret_cast<const bf16x8*>(p); }
  __device__ __forceinline__ bool skip(int, int) const { return false; }
  template <int NQ> __device__ __forceinline__ void fixq(bf16x8 (&)[NQ], int, int) const {}
};
struct FDense : FBase {
  const bf16_t* Q; bf16_t* O; int ldq, ldo; long k0;
  __device__ __forceinline__ const bf16_t* qptr(int row) const { return Q + (size_t)row * ldq; }
  __device__ __forceinline__ bf16_t* optr(int row) const { return O + (size_t)row * ldo; }
  __device__ __forceinline__ long key0(int j) const { return k0 + 64 * j; }
};
struct FCross : FDense {
  size_t slab; const float* ss; int row0g;
  __device__ __forceinline__ bf16x8 loadq(const bf16_t* p) const { return *reinterpret_cast<const bf16x8*>(p); }
  template <int NQ> __device__ __forceinline__ void fixq(bf16x8 (&qr)[NQ], int row, int hi) const {
    const float* sp = ss + (size_t)(row0g + row) * 32; float sq = 0.f;
#pragma unroll
    for (int i = 0; i < 8; ++i) { const f32x4 p = *(const f32x4*)(sp + 4 * i); sq += (p[0] + p[1]) + (p[2] + p[3]); }
    const float rs = 1.0f / sqrtf(sq * (1.0f / DM) + EPS);
    const bf16_t* q1 = Q + (size_t)row * ldq + hi * 8 + slab;
#pragma unroll
    for (int d = 0; d < NQ; ++d) { float a[8];
      { const u32x4 w = *reinterpret_cast<const u32x4*>(&qr[d]); a[0] = bf2f(w.x & 0xffffu); a[1] = bf2f(w.x >> 16); a[2] = bf2f(w.y & 0xffffu); a[3] = bf2f(w.y >> 16); a[4] = bf2f(w.z & 0xffffu); a[5] = bf2f(w.z >> 16); a[6] = bf2f(w.w & 0xffffu); a[7] = bf2f(w.w >> 16); }
#pragma unroll
      for (int k = 0; k < 3; ++k) { const u32x4 w = *(const u32x4*)(q1 + k * slab + d * 16);
        a[0] += bf2f(w.x & 0xffffu); a[1] += bf2f(w.x >> 16); a[2] += bf2f(w.y & 0xffffu); a[3] += bf2f(w.y >> 16); a[4] += bf2f(w.z & 0xffffu); a[5] += bf2f(w.z >> 16); a[6] += bf2f(w.w & 0xffffu); a[7] += bf2f(w.w >> 16); }
      u32x4 o = {cvtpk(a[0] * rs, a[1] * rs), cvtpk(a[2] * rs, a[3] * rs), cvtpk(a[4] * rs, a[5] * rs), cvtpk(a[6] * rs, a[7] * rs)}; qr[d] = *reinterpret_cast<bf16x8*>(&o); }
  }
};
struct FMla : FDense {
  const float* tab; int pos0;
  template <int NQ> __device__ __forceinline__ void fixq(bf16x8 (&qr)[NQ], int row, int hi) const {
#pragma unroll
    for (int d = 8; d < 10; ++d) { const float* cs = tab + 2 * ((size_t)(pos0 + row) * 32 + (d - 8) * 16 + hi * 8);
      const f32x4 c0 = *(const f32x4*)cs, c1 = *(const f32x4*)(cs + 4), c2 = *(const f32x4*)(cs + 8), c3 = *(const f32x4*)(cs + 12);
      const float co[8] = {c0[0], c0[2], c1[0], c1[2], c2[0], c2[2], c3[0], c3[2]}, si[8] = {c0[1], c0[3], c1[1], c1[3], c2[1], c2[3], c3[1], c3[3]};
      float y1[8], y2[8];
#pragma unroll
      for (int e = 0; e < 8; ++e) { const float x1 = bf2f((unsigned)(unsigned short)qr[d][e]), x2 = bf2f((unsigned)(unsigned short)qr[d + 2][e]); y1[e] = x1 * co[e] - x2 * si[e]; y2[e] = x2 * co[e] + x1 * si[e]; }
      u32x4 w1 = {cvtpk(y1[0], y1[1]), cvtpk(y1[2], y1[3]), cvtpk(y1[4], y1[5]), cvtpk(y1[6], y1[7])}, w2 = {cvtpk(y2[0], y2[1]), cvtpk(y2[2], y2[3]), cvtpk(y2[4], y2[5]), cvtpk(y2[6], y2[7])};
      qr[d] = *reinterpret_cast<bf16x8*>(&w1); qr[d + 2] = *reinterpret_cast<bf16x8*>(&w2); }
  }
};
struct FWin : FDense {
  int qpos0, kpos0; float sink_raw;
  __device__ __forceinline__ float l_init() const { return 1.f; }
  __device__ __forceinline__ float m_init(int) const { return sink_raw; }
  __device__ __forceinline__ bool skip(int j, int wid) const { const int kmin = kpos0 + 64 * j, qmin = qpos0 + 32 * wid; return kmin > qmin + 31 + 128 || kmin + 63 < qmin - 128; }
  __device__ __forceinline__ void apply(f32x16& p0, f32x16& p1, int j, int row, int hi) const {
    const int d0 = kpos0 + 64 * j - (qpos0 + row);
    const float ninf = -__builtin_inff();
#pragma unroll
    for (int r = 0; r < 16; ++r) { const int d = d0 + crow(r, hi);
      p0[r] = (d >= -128 && d <= 128) ? p0[r] : ninf; p1[r] = (d + 32 >= -128 && d + 32 <= 128) ? p1[r] : ninf; }
  }
};
struct FNat : FBase {
  const bf16_t* Q; bf16_t* O; long tok0; int kvh, rq, rb; const float* bias;
  __device__ __forceinline__ const bf16_t* qptr(int row) const { return Q + (size_t)(tok0 + (row & 63)) * GQA_IN + (kvh * 4 + (row >> 6)) * HD; }
  __device__ __forceinline__ bf16_t* optr(int row) const { return O + (size_t)(tok0 + (row & 63)) * DM + (kvh * 4 + (row >> 6)) * HD; }
  __device__ __forceinline__ long key0(int j) const { return tok0 + (long)(rb + j - rq) * 64; }
  __device__ __forceinline__ void apply(f32x16& p0, f32x16& p1, int j, int row, int hi) const {
    const int g = row >> 6, qc = row & 63; int cs = qc - 8; cs = cs < 0 ? 0 : (cs > 48 ? 48 : cs);
    const int dr = rb + j - rq + 7;
    const float* bt = bias + g * 465 + dr * 31 + 15 - qc;
    const float ninf = -__builtin_inff();
#pragma unroll
    for (int r = 0; r < 16; ++r) { const int kc = crow(r, hi);
      { const bool ok = (kc >= cs) && (kc < cs + 16); const float bv = ok ? bt[kc] : 0.f; p0[r] = ok ? p0[r] + bv : ninf; }
      { const int k2 = kc + 32; const bool ok = (k2 >= cs) && (k2 < cs + 16); const float bv = ok ? bt[k2] : 0.f; p1[r] = ok ? p1[r] + bv : ninf; } }
  }
};
}

__device__ __forceinline__ void row_load(const float* p, int lane, f32x4 (&v)[8]) {
#pragma unroll
    for (int j = 0; j < 8; ++j) v[j] = *(const f32x4*)(p + 4 * lane + 256 * j);
}
__device__ __forceinline__ float row_rstd(const f32x4 (&v)[8]) {
    float s = 0.f;
#pragma unroll
    for (int j = 0; j < 8; ++j) s += (v[j].x * v[j].x + v[j].y * v[j].y) + (v[j].z * v[j].z + v[j].w * v[j].w);
    return 1.0f / sqrtf(wave_sum(s) * (1.0f / DM) + EPS);
}
__device__ __forceinline__ void row_store_norm_bf16(bf16_t* o, const float* g, int lane, const f32x4 (&v)[8], float rstd) {
#pragma unroll
    for (int j = 0; j < 8; ++j) { const f32x4 gg = *(const f32x4*)(g + 4 * lane + 256 * j);
        u32x2 w; w.x = cvtpk(v[j].x * rstd * gg.x, v[j].y * rstd * gg.y); w.y = cvtpk(v[j].z * rstd * gg.z, v[j].w * rstd * gg.w);
        *(u32x2*)(o + 4 * lane + 256 * j) = w; }
}
__device__ __forceinline__ void rowb_load(const bf16_t* p, int lane, f32x4 (&v)[8]) {
#pragma unroll
    for (int j = 0; j < 8; ++j) { const u32x2 w = *(const u32x2*)(p + 4 * lane + 256 * j); v[j] = (f32x4){bf2f(w.x & 0xffffu), bf2f(w.x >> 16), bf2f(w.y & 0xffffu), bf2f(w.y >> 16)}; }
}
__device__ __forceinline__ void rowb_store(bf16_t* p, int lane, const f32x4 (&v)[8]) {
#pragma unroll
    for (int j = 0; j < 8; ++j) { u32x2 w; w.x = cvtpk(v[j].x, v[j].y); w.y = cvtpk(v[j].z, v[j].w); *(u32x2*)(p + 4 * lane + 256 * j) = w; }
}
__device__ __forceinline__ void row_add_y(f32x4 (&v)[8], const u32x2 (&w)[8]) {
#pragma unroll
    for (int j = 0; j < 8; ++j) { v[j].x += bf2f(w[j].x & 0xffffu); v[j].y += bf2f(w[j].x >> 16); v[j].z += bf2f(w[j].y & 0xffffu); v[j].w += bf2f(w[j].y >> 16); }
}
__device__ __forceinline__ void row_combine(f32x4 (&v)[8], const int* slot_row, const bf16_t* Y, int b, int lane) {
    const int myslot = lane < NE ? slot_row[lane] : -1;
    unsigned long long m = __ballot(myslot >= 0);
#pragma unroll 1
    while (m) {
        const int e0 = __builtin_ctzll(m); m &= m - 1; const bool two = m != 0; const int e1 = two ? __builtin_ctzll(m) : e0; if (two) m &= m - 1;
        const int s0 = __builtin_amdgcn_readlane(myslot, e0), s1 = __builtin_amdgcn_readlane(myslot, e1);
        const bf16_t* y0 = Y + ((size_t)(b * NE + e0) * CAP + s0) * DM; const bf16_t* y1 = Y + ((size_t)(b * NE + e1) * CAP + s1) * DM;
        u32x2 w0[8], w1[8];
#pragma unroll
        for (int j = 0; j < 8; ++j) { w0[j] = *(const u32x2*)(y0 + 4 * lane + 256 * j); w1[j] = *(const u32x2*)(y1 + 4 * lane + 256 * j); }
        row_add_y(v, w0); if (two) row_add_y(v, w1);
    }
}
struct RowPre { u32x2 w[8]; int slot; };
__device__ __forceinline__ void rowpre_load(RowPre& p, const bf16_t* hrow, const int* slot_row, int lane) {
#pragma unroll
    for (int j = 0; j < 8; ++j) p.w[j] = *(const u32x2*)(hrow + 4 * lane + 256 * j);
    p.slot = lane < NE ? slot_row[lane] : -1;
}
__device__ __forceinline__ void rowpre_unpack(const RowPre& p, f32x4 (&v)[8]) {
#pragma unroll
    for (int j = 0; j < 8; ++j) v[j] = (f32x4){bf2f(p.w[j].x & 0xffffu), bf2f(p.w[j].x >> 16), bf2f(p.w[j].y & 0xffffu), bf2f(p.w[j].y >> 16)};
}
__device__ __forceinline__ void row_combine_s(f32x4 (&v)[8], int myslot, const bf16_t* Y, int b, int lane) {
    unsigned long long m = __ballot(myslot >= 0);
#pragma unroll 1
    while (m) {
        const int e0 = __builtin_ctzll(m); m &= m - 1; const bool two = m != 0; const int e1 = two ? __builtin_ctzll(m) : e0; if (two) m &= m - 1;
        const int s0 = __builtin_amdgcn_readlane(myslot, e0), s1 = __builtin_amdgcn_readlane(myslot, e1);
        const bf16_t* y0 = Y + ((size_t)(b * NE + e0) * CAP + s0) * DM; const bf16_t* y1 = Y + ((size_t)(b * NE + e1) * CAP + s1) * DM;
        u32x2 w0[8], w1[8];
#pragma unroll
        for (int j = 0; j < 8; ++j) { w0[j] = *(const u32x2*)(y0 + 4 * lane + 256 * j); w1[j] = *(const u32x2*)(y1 + 4 * lane + 256 * j); }
        row_add_y(v, w0); if (two) row_add_y(v, w1);
    }
}
__device__ __forceinline__ void transpose_item(const float* W, int N, bf16_t* WT, int ldk, int k0, int n0, int drow0, LAS float* scr, int lane, const float* gk) {
    const int krow = lane >> 3, n4 = lane & 7;
    const float* p0 = W + (size_t)(k0 + krow) * N + n0 + 4 * n4; const size_t st = (size_t)8 * N;
    f32x4 r[8];
#pragma unroll
    for (int i = 0; i < 8; ++i) r[i] = __builtin_nontemporal_load((const f32x4*)(p0 + i * st));
#pragma unroll
    for (int i = 0; i < 8; ++i) { LAS float* q = scr + (8 * i + krow) * 33 + 4 * n4; q[0] = r[i].x; q[1] = r[i].y; q[2] = r[i].z; q[3] = r[i].w; }
    const int c = lane & 7;
    f32x4 g0 = {1.f, 1.f, 1.f, 1.f}, g1 = {1.f, 1.f, 1.f, 1.f}; if (gk) { g0 = *(const f32x4*)(gk + k0 + 8 * c); g1 = *(const f32x4*)(gk + k0 + 8 * c + 4); }
    asm volatile("s_waitcnt lgkmcnt(0)" ::: "memory");
#pragma unroll
    for (int j = 0; j < 4; ++j) { const int n = (lane >> 3) + 8 * j; const LAS float* s = scr + (8 * c) * 33 + n;
        u32x4 o; o.x = cvtpk(s[0 * 33] * g0[0], s[1 * 33] * g0[1]); o.y = cvtpk(s[2 * 33] * g0[2], s[3 * 33] * g0[3]); o.z = cvtpk(s[4 * 33] * g1[0], s[5 * 33] * g1[1]); o.w = cvtpk(s[6 * 33] * g1[2], s[7 * 33] * g1[3]);
        __builtin_nontemporal_store(o, (u32x4*)(WT + (size_t)(drow0 + n) * ldk + k0 + 8 * c)); }
    asm volatile("s_waitcnt lgkmcnt(0)" ::: "memory");
}

__device__ __forceinline__ void bg_drain(bgw::Work& w, int lane) {
    w.pend0 = 0; w.pend1 = 0;
#pragma unroll 1
    for (; w.cur < w.end; ++w.cur) { const bgw::Item t = w.decode(w.cur); transpose_item(t.src, t.N, t.dst, t.K, t.k0, t.n0, t.drow0, w.scr, lane, t.gk); }
}

struct Args { const float* in[30]; float* out; unsigned char* ws; int ph_lo, ph_hi, flags, pad; };
static_assert(true, "");
enum { IN_X = 0, IN_MEM, IN_GMIX, IN_GXA, IN_GFFN, IN_A_WIN, IN_A_SINK, IN_A_WOUT, IN_B_WIN, IN_B_QG, IN_B_KG, IN_B_WOUT, IN_C_WIN, IN_C_QLG, IN_C_KVLG, IN_C_WUQ, IN_C_WUKV, IN_C_WOUT,
       IN_D_WIN, IN_D_RPB, IN_D_WOUT, IN_MEMG, IN_XA_WQ, IN_XA_WKV, IN_XA_WO, IN_ROUTER, IN_M_GATE, IN_M_UP, IN_M_DOWN, IN_FINALG };
constexpr int PH_PER_LAYER = 15, PH_FINAL = 1 + 4 * PH_PER_LAYER, N_PHASES = PH_FINAL + 1;

__global__ void __launch_bounds__(512, 2) fwd(Args args) {
    extern __shared__ __attribute__((aligned(16))) unsigned char lds[];
    LAS unsigned char* ldsl = (LAS unsigned char*)lds;
    const int wave0 = __builtin_amdgcn_readfirstlane(threadIdx.x >> 6), G0 = gridDim.x, bx0 = blockIdx.x;
#define TID0 (opq_s(wave0) * 64 + (int)__builtin_amdgcn_mbcnt_hi(~0u, __builtin_amdgcn_mbcnt_lo(~0u, (unsigned)opq_s(0))))
    const int tid0 = TID0;
    for (int u = tid0; u < (LDS_BYTES - LDSCTL_OFF) / 4; u += 512) ((LAS unsigned*)(ldsl + LDSCTL_OFF))[u] = 0u;
    __syncthreads();
    volatile LAS unsigned long long* ptab = (volatile LAS unsigned long long*)(ldsl + LDSCTL_OFF + 256);
    if (tid0 < 30) ptab[tid0] = (unsigned long long)args.in[tid0];
    __syncthreads();
    XcdBarrier bar = xcd_barrier_post((unsigned*)(args.ws + WS_CTL) + 1024, (volatile LAS unsigned*)(ldsl + LDSCTL_OFF + 64), tid0);
    const int lo = args.ph_lo, hi = args.ph_hi;
#define IN(k) (lo <= (k) && (k) < hi)
#define SEAM(k) do { if (IN(k) && (k) + 1 < hi) xcd_barrier(bar, TID0); } while (0)

#define WSP unsigned char* ws = opaque(args.ws); const int tid = opq_v(TID0), lane = tid & 63, wave = __builtin_amdgcn_readfirstlane(tid >> 6); \
    const int G = opq_s(G0), bx = opq_s(bx0), vcu = (G % 8 == 0) ? (bx % 8) * (G / 8) + bx / 8 : bx, gw = vcu * 8 + wave, NGW = G * 8; (void)lane; (void)gw; (void)NGW; (void)vcu
#define XIN (ldp(ptab, IN_X))
#define H ((float*)(ws + A_H))
#define XN ((bf16_t*)(ws + A_XN))
#define QKV ((bf16_t*)(ws + A_QKV))
#define KM ((bf16_t*)(ws + A_KM))
#define VM ((bf16_t*)(ws + A_VM))
#define LAT ((float*)(ws + A_LAT))
#define CN ((bf16_t*)(ws + A_CN))
#define OB ((bf16_t*)(ws + A_O))
#define QX ((bf16_t*)(ws + A_QX))
#define OX ((bf16_t*)(ws + A_OX))
#define KVX ((bf16_t*)(ws + A_KVX))
#define MEMN ((bf16_t*)(ws + A_MEMN))
#define XG ((bf16_t*)(ws + A_XG))
#define HMID ((bf16_t*)(ws + A_HMID))
#define YB ((bf16_t*)(ws + A_Y))
#define AFF ((float*)(ws + WS_AFF))
#define IDX ((int*)(ws + WS_IDX))
#define GATE ((float*)(ws + WS_GATE))
#define SLOT ((int*)(ws + WS_SLOT))
#define TABA ((float*)(ws + WS_TABA))
#define TABBR ((float*)(ws + WS_TABBR))
#define TABBC ((float*)(ws + WS_TABBC))
#define TABC ((float*)(ws + WS_TABC))
#define SS2 ((float*)(ws + WS_SS2))
#define RS1 ((float*)(ws + WS_RS1))
#define RS3 ((float*)(ws + WS_RS3))
#define RSG ((float*)(ws + WS_RSG))
#define HB ((bf16_t*)(ws + A_H))

    if (EN(15) && IN(0)) for (int rep_ = 0, L_ = 0; rep_ < REPS(15); ++rep_) { WSP;
        LAS float* scr = (LAS float*)(ldsl + wave * 16384);
        long base = 0;
#pragma unroll 1
        for (int f = 0; f < (BG_CONVERT ? 13 : (SIDE_DOWN ? 15 : 16)); ++f) {
            const float* src; bf16_t* dst; int nmat, K, N, mode = 0; size_t dstride = 0; const float* gsrc = nullptr; int gdiv = 1;
            switch (f) {
                case 0:  src = ldp(ptab, IN_A_WIN);  dst = (bf16_t*)(ws + W_A_IN);  nmat = 1; K = 2048; N = 3072; gsrc = ldp(ptab, IN_GMIX) + 0 * DM; break;
                case 1:  src = ldp(ptab, IN_A_WOUT); dst = (bf16_t*)(ws + W_A_OUT); nmat = 1; K = 2048; N = 2048; break;
                case 2:  src = ldp(ptab, IN_B_WIN);  dst = (bf16_t*)(ws + W_B_IN);  nmat = 1; K = 2048; N = 3072; gsrc = ldp(ptab, IN_GMIX) + 1 * DM; break;
                case 3:  src = ldp(ptab, IN_B_WOUT); dst = (bf16_t*)(ws + W_B_OUT); nmat = 1; K = 2048; N = 2048; break;
                case 4:  src = ldp(ptab, IN_D_WIN);  dst = (bf16_t*)(ws + W_D_IN);  nmat = 1; K = 2048; N = 3072; gsrc = ldp(ptab, IN_GMIX) + 3 * DM; break;
                case 5:  src = ldp(ptab, IN_D_WOUT); dst = (bf16_t*)(ws + W_D_OUT); nmat = 1; K = 2048; N = 2048; break;
                case 6:  src = ldp(ptab, IN_C_WIN);  dst = (bf16_t*)(ws + W_C_IN);  nmat = 1; K = 2048; N = MLA_IN; gsrc = ldp(ptab, IN_GMIX) + 2 * DM; break;
                case 7:  src = ldp(ptab, IN_C_WUQ);  dst = (bf16_t*)(ws + W_C_UQ);  nmat = 1; K = 512;  N = 3072; break;
                case 8:  src = ldp(ptab, IN_C_WUKV); dst = (bf16_t*)(ws + W_C_UKV); nmat = 1; K = 512;  N = 4096; break;
                case 9:  src = ldp(ptab, IN_C_WOUT); dst = (bf16_t*)(ws + W_C_OUT); nmat = 1; K = 2048; N = 2048; break;
                case 10: src = ldp(ptab, IN_XA_WQ);  dst = (bf16_t*)(ws + W_XQ);    nmat = 4; K = 2048; N = 512;  dstride = (size_t)512 * 2048; gsrc = ldp(ptab, IN_GXA); break;
                case 11: src = ldp(ptab, IN_XA_WKV); dst = (bf16_t*)(ws + W_XKV);   nmat = 4; K = 2048; N = 1024; dstride = (size_t)1024 * 2048; break;
                case 12: src = ldp(ptab, IN_XA_WO);  dst = (bf16_t*)(ws + W_XO);    nmat = 4; K = 512;  N = 2048; dstride = (size_t)2048 * 512; break;
                case 13: src = ldp(ptab, IN_M_GATE); dst = (bf16_t*)(ws + W_M1);    nmat = PIGGY ? 48 : 64; K = 2048; N = 1024; dstride = (size_t)2048 * 2048; mode = 1; gsrc = ldp(ptab, IN_GFFN); gdiv = 16; break;
                case 14: src = ldp(ptab, IN_M_UP);   dst = (bf16_t*)(ws + W_M1);    nmat = PIGGY ? 48 : 64; K = 2048; N = 1024; dstride = (size_t)2048 * 2048; mode = 2; gsrc = ldp(ptab, IN_GFFN); gdiv = 16; break;
                default: src = ldp(ptab, IN_M_DOWN); dst = (bf16_t*)(ws + W_M2);    nmat = PIGGY ? (SIDE_K1 && G == 256 ? 20 : 32) : 64; K = 1024; N = 2048; dstride = (size_t)2048 * 1024; break;
            }
            const int nblk = N / 32, per = (K / 64) * nblk; const long total = (long)nmat * per;
            long it = ((long)gw - (base % NGW) + NGW) % NGW;
#pragma unroll 1
            for (; it < total; it += NGW) {
                int mat = (int)(it / per); const int r = (int)(it % per), kb = r / nblk, nb = r % nblk, n0 = 32 * nb;
                if (PIGGY && f >= 13 && mat >= 16) mat += (f == 15 ? (SIDE_K1 && G == 256 ? 44 : 32) : 16);
                if (SIDE_X && f == 13 && (mat & 15) < 8) continue;
                const int drow0 = mode == 0 ? n0 : ((n0 >> 7) * 256 + (n0 & 127) + (mode == 2 ? 128 : 0));
                transpose_item(src + (size_t)mat * K * N, N, dst + (size_t)mat * dstride, K, 64 * kb, n0, drow0, scr, lane, gsrc ? gsrc + (size_t)(mat / gdiv) * K : nullptr);
            }
            base += total;
        }
        {
            u32x4* z = (u32x4*)((bf16_t*)(ws + W_C_IN) + (size_t)MLA_IN * 2048); const int nz = (MLA_INP - MLA_IN) * 2048 / 8;
            for (int i = gw * 64 + lane; i < nz; i += NGW * 64) z[i] = (u32x4){0u, 0u, 0u, 0u};
        }
        for (int m = gw; m < NB * MEMT + T; m += NGW) {
            f32x4 v[8];
            if (m < NB * MEMT) { row_load(ldp(ptab, IN_MEM) + (size_t)m * DM, lane, v); const float rstd = row_rstd(v); row_store_norm_bf16(MEMN + (size_t)m * DM, ldp(ptab, IN_MEMG), lane, v, rstd); }
            else { const int t = m - NB * MEMT; row_load(XIN + (size_t)t * DM, lane, v); const float rstd = row_rstd(v); rowb_store(HB + (size_t)t * DM, lane, v); if (lane == 0) RS1[t] = rstd; }
        }
        for (int i = gw * 64 + lane; i < 2048 * 16 + 32 * 32 + 64 * 32 + 2048 * 32; i += NGW * 64) {
            int j = i; float* dst; float pos, fr;
            if (j < 2048 * 16) { pos = (float)(j >> 4); fr = exp2f(-(float)(2 * (j & 15)) / 32.0f * 18.931568569324174f); dst = TABA + 2 * j; }
            else { j -= 2048 * 16;
                if (j < 32 * 32) { pos = (float)(j >> 5); fr = exp2f(-(float)(2 * (j & 31)) / 64.0f * 13.287712379549449f); dst = TABBR + 2 * j; }
                else { j -= 32 * 32;
                    if (j < 64 * 32) { pos = (float)(j >> 5); fr = exp2f(-(float)(2 * (j & 31)) / 64.0f * 13.287712379549449f); dst = TABBC + 2 * j; }
                    else { j -= 64 * 32; pos = (float)(j >> 5); fr = exp2f(-(float)(2 * (j & 31)) / 64.0f * 18.931568569324174f); dst = TABC + 2 * j; } } }
            const float ang = pos * fr; dst[0] = cosf(ang); dst[1] = sinf(ang);
        }
        for (int i = gw * 64 + lane; i < 4 * 4096; i += NGW * 64) {
            const int Lr = i >> 12, kk = (i >> 6) & 63, l = i & 63, d0 = kk * 32 + (l >> 4) * 8;
            const float* wsrc = ldp(ptab, IN_ROUTER) + ((size_t)Lr * DM + d0) * NE + (l & 15); const float* gs = ldp(ptab, IN_GFFN) + Lr * DM + d0;
            u32x4 hi4, lo4;
#pragma unroll
            for (int j = 0; j < 4; ++j) { const float w0 = wsrc[(2 * j) * NE] * gs[2 * j], w1 = wsrc[(2 * j + 1) * NE] * gs[2 * j + 1];
                const unsigned hp = cvtpk(w0, w1); hi4[j] = hp; lo4[j] = cvtpk(w0 - __uint_as_float(hp << 16), w1 - __uint_as_float(hp & 0xffff0000u)); }
            u32x4* rw = (u32x4*)(ws + WS_RW) + (size_t)Lr * 8192 + (i & 4095); rw[0] = hi4; rw[4096] = lo4;
        }
    }
    SEAM(0);

#pragma unroll 1
    for (int L = 0; L < 4; ++L) {
        const int P = 1 + L * PH_PER_LAYER; const int L_ = L; (void)L_;
        if (EN(0) && L > 0 && IN(P + 0)) for (int rep_ = 0; rep_ < REPS(0); ++rep_) { WSP;
            bf16_t* hout = (bf16_t*)(ws + A_H + (size_t)(args.flags & 1) * (A_TRASH - A_H));
            for (int t = gw; t < T; t += NGW) {
                f32x4 v[8]; rowb_load(HB + (size_t)t * DM, lane, v);
                row_combine(v, SLOT + (size_t)t * NE, YB, t / SEQ, lane);
                rowb_store(hout + (size_t)t * DM, lane, v);
                const float rstd = row_rstd(v); if (lane == 0) RS1[t] = rstd;
            }
        }
        if (L > 0) SEAM(P + 0);
        if (EN(1) && IN(P + 1)) for (int rep_ = 0; rep_ < REPS(1); ++rep_) { WSP;
            if (L == 2) {
                pg8::PlainOrder S; S.init(HB, ws + W_C_IN, DM, DM, T, MLA_INP, G, bx);
                pg8::EpiF32RS1 E{LAT, MLA_INP, RS1};
                pg8::gemm_phase<pg8::EpiF32RS1, pg8::PlainOrder>(ldsl, tid, DM, DM, DM, S, E);
            } else {
                const size_t wo = L == 0 ? W_A_IN : (L == 1 ? W_B_IN : W_D_IN);
                pg8::PlainOrder S; S.init(HB, ws + wo, DM, DM, T, GQA_IN, G, bx);
                pg8::EpiBf16RS1 E{QKV, GQA_IN, RS1};
                pg8::gemm_phase<pg8::EpiBf16RS1, pg8::PlainOrder>(ldsl, tid, DM, DM, DM, S, E);
                if (SIDE_K1 && PIGGY && rep_ == 0 && G == 256 && bx >= (L == 0 ? 192 : 128)) {
                    const int nw = (L == 0 ? 64 : 128) * 8, w0 = (bx - (L == 0 ? 192 : 128)) * 8 + wave, nit = (L == 0 ? 4 : 8) * 1024, mat0 = L == 1 ? 32 : (L == 3 ? 48 : 56);
                    LAS float* scr = (LAS float*)(ldsl + wave * 16384); const float* wd = ldp(ptab, IN_M_DOWN);
#pragma unroll 1
                    for (int it = w0; it < nit; it += nw) { const int mat = mat0 + (it >> 10), r = it & 1023, kb = r >> 6, n0 = (r & 63) * 32;
                        transpose_item(wd + (size_t)mat * 1024 * 2048, 2048, (bf16_t*)(ws + W_M2) + (size_t)mat * 2048 * 1024, 1024, 64 * kb, n0, n0, scr, lane, nullptr); }
                }
                if (L == 0) {
#pragma unroll 1
                    for (int l = 0; l < 4; ++l) {
                        pg8::PlainOrder S2; S2.init(MEMN, ws + W_XKV + (size_t)l * 1024 * 2048 * 2, DM, DM, NB * MEMT, 1024, G, (bx + 2 * G - G / 2 - 16 * l) % G);
                        pg8::EpiBf16 E2{KVX + (size_t)l * 1024 * 1024, 1024};
                        pg8::gemm_phase<pg8::EpiBf16, pg8::PlainOrder>(ldsl, tid, DM, DM, DM, S2, E2);
                    }
                }
            }
        }
        SEAM(P + 1);
        if (EN(2) && L != 3 && IN(P + 2)) for (int rep_ = 0; rep_ < REPS(2); ++rep_) { WSP;
            if (L == 0) {
                for (int i = gw * 64 + lane; i < T * 20; i += NGW * 64) {
                    const int tk = i / 20, hd = i % 20;
                    u32x4* p = (u32x4*)(QKV + (size_t)tk * GQA_IN + hd * HD); const f32x4* cs = (const f32x4*)(TABA + 2 * ((tk % SEQ) * 16));
                    const u32x4 a0 = p[0], a1 = p[1], b0 = p[2], b1 = p[3];
                    f32x4 t[8];
#pragma unroll
                    for (int q = 0; q < 8; ++q) t[q] = cs[q];
                    const unsigned xa[8] = {a0.x, a0.y, a0.z, a0.w, a1.x, a1.y, a1.z, a1.w}, xb[8] = {b0.x, b0.y, b0.z, b0.w, b1.x, b1.y, b1.z, b1.w};
                    unsigned oa[8], ob[8];
#pragma unroll
                    for (int q = 0; q < 8; ++q) { const float x1l = bf2f(xa[q] & 0xffffu), x1h = bf2f(xa[q] >> 16), x2l = bf2f(xb[q] & 0xffffu), x2h = bf2f(xb[q] >> 16);
                        oa[q] = cvtpk(x1l * t[q][0] - x2l * t[q][1], x1h * t[q][2] - x2h * t[q][3]); ob[q] = cvtpk(x2l * t[q][0] + x1l * t[q][1], x2h * t[q][2] + x1h * t[q][3]); }
                    p[0] = (u32x4){oa[0], oa[1], oa[2], oa[3]}; p[1] = (u32x4){oa[4], oa[5], oa[6], oa[7]}; p[2] = (u32x4){ob[0], ob[1], ob[2], ob[3]}; p[3] = (u32x4){ob[4], ob[5], ob[6], ob[7]};
                }
            } else if (L == 1) {
                const float* qg = ldp(ptab, IN_B_QG); const float* kg = ldp(ptab, IN_B_KG);
                const int l16 = lane & 15, sub = lane >> 4;
#pragma unroll 1
                for (int i0 = gw; i0 < T * 5; i0 += 2 * NGW) {
                    u32x4 xin[2]; u32x4* pp[2]; int spos[2]; bool isq[2], ok[2];
#pragma unroll
                    for (int u = 0; u < 2; ++u) { const int i = i0 + u * NGW; ok[u] = i < T * 5; const int ii = ok[u] ? i : i0; const int tk = ii / 5, hd = (ii % 5) * 4 + sub; spos[u] = tk % SEQ; isq[u] = hd < NH;
                        pp[u] = (u32x4*)(QKV + (size_t)tk * GQA_IN + hd * HD + 8 * l16); xin[u] = *pp[u]; }
#pragma unroll
                    for (int u = 0; u < 2; ++u) {
                        const unsigned xw[4] = {xin[u].x, xin[u].y, xin[u].z, xin[u].w}; float a[8]; float ss = 0.f;
#pragma unroll
                        for (int q = 0; q < 4; ++q) { a[2 * q] = bf2f(xw[q] & 0xffffu); a[2 * q + 1] = bf2f(xw[q] >> 16); ss += a[2 * q] * a[2 * q] + a[2 * q + 1] * a[2 * q + 1]; }
                        ss += __shfl_xor(ss, 1); ss += __shfl_xor(ss, 2); ss += __shfl_xor(ss, 4); ss += __shfl_xor(ss, 8);
                        const float rstd = 1.0f / sqrtf(ss * (1.0f / HD) + EPS);
                        const float* g = (isq[u] ? qg : kg) + 8 * l16; const f32x4 g0 = *(const f32x4*)g, g1 = *(const f32x4*)(g + 4);
                        const float gg[8] = {g0[0], g0[1], g0[2], g0[3], g1[0], g1[1], g1[2], g1[3]};
                        const float* cs = (l16 < 8 ? TABBR + 2 * ((spos[u] >> 6) * 32 + 8 * (l16 & 3)) : TABBC + 2 * ((spos[u] & 63) * 32 + 8 * (l16 & 3)));
                        const f32x4 c0 = *(const f32x4*)cs, c1 = *(const f32x4*)(cs + 4), c2 = *(const f32x4*)(cs + 8), c3 = *(const f32x4*)(cs + 12);
                        const float co[8] = {c0[0], c0[2], c1[0], c1[2], c2[0], c2[2], c3[0], c3[2]}, si[8] = {c0[1], c0[3], c1[1], c1[3], c2[1], c2[3], c3[1], c3[3]};
                        const float sg = (l16 & 4) ? 1.f : -1.f; float o[8];
#pragma unroll
                        for (int e = 0; e < 8; ++e) { a[e] = a[e] * rstd * gg[e]; const float pb = __shfl_xor(a[e], 4); o[e] = a[e] * co[e] + sg * pb * si[e]; }
                        if (ok[u]) *pp[u] = (u32x4){cvtpk(o[0], o[1]), cvtpk(o[2], o[3]), cvtpk(o[4], o[5]), cvtpk(o[6], o[7])};
                    }
                }
            } else {
                for (int tk = gw; tk < T; tk += NGW) {
                    const float* lr = LAT + (size_t)tk * MLA_INP;
#pragma unroll
                    for (int part = 0; part < 2; ++part) {
                        const f32x4 u0 = *(const f32x4*)(lr + part * 512 + 8 * lane), u1 = *(const f32x4*)(lr + part * 512 + 8 * lane + 4);
                        const float ss = (u0.x * u0.x + u0.y * u0.y) + (u0.z * u0.z + u0.w * u0.w) + (u1.x * u1.x + u1.y * u1.y) + (u1.z * u1.z + u1.w * u1.w);
                        const float rstd = 1.0f / sqrtf(wave_sum(ss) * (1.0f / 512.0f) + EPS);
                        const float* g = (part == 0 ? ldp(ptab, IN_C_QLG) : ldp(ptab, IN_C_KVLG)) + 8 * lane;
                        const f32x4 g0 = *(const f32x4*)g, g1 = *(const f32x4*)(g + 4);
                        u32x4 w; w.x = cvtpk(u0.x * rstd * g0.x, u0.y * rstd * g0.y); w.y = cvtpk(u0.z * rstd * g0.z, u0.w * rstd * g0.w);
                        w.z = cvtpk(u1.x * rstd * g1.x, u1.y * rstd * g1.y); w.w = cvtpk(u1.z * rstd * g1.z, u1.w * rstd * g1.w);
                        *(u32x4*)(CN + (size_t)tk * 1024 + part * 512 + 8 * lane) = w;
                    }
                    const float a = lr[1024 + lane], b = __shfl_xor(a, 32);
                    const float* cs = TABC + 2 * ((tk % SEQ) * 32 + (lane & 31));
                    const bf16_t o = f2bf(lane < 32 ? a * cs[0] - b * cs[1] : a * cs[0] + b * cs[1]);
                    bf16_t* kp = KM + (size_t)tk * 3072 + 128 + lane;
#pragma unroll
                    for (int h = 0; h < NH; ++h) kp[h * 192] = o;
                }
            }
        }
        if (L != 3) SEAM(P + 2);
        if (EN(3) && L == 2 && IN(P + 3)) for (int rep_ = 0; rep_ < REPS(3); ++rep_) { WSP;
            { pg8::PlainOrder S; S.init(CN, ws + W_C_UQ, 1024, 512, T, 3072, G, bx);
              pg8::EpiBf16 E{QKV, 3072};
              pg8::gemm_phase<pg8::EpiBf16, pg8::PlainOrder>(ldsl, tid, 512, 1024, 512, S, E); }
            { pg8::PlainOrder S; S.init(CN + 512, ws + W_C_UKV, 1024, 512, T, 4096, G, G - 1 - bx);
              pg8::EpiMlaKV E{KM, VM};
              pg8::gemm_phase<pg8::EpiMlaKV, pg8::PlainOrder>(ldsl, tid, 512, 1024, 512, S, E); }
        }
        if (L == 2) SEAM(P + 3);
        if (EN(5) && IN(P + 5)) for (int rep_ = 0; rep_ < REPS(5); ++rep_) { WSP;
            char* al = (char*)lds;
            bgw::NoWork nobg; bgw::Work bgwk; (void)nobg;
            {
                const int kind = (PIGGY && rep_ == 0 && L == 1) ? (SIDE_K1 && G == 256 ? 4 : 2) : 0, setsize = kind == 2 ? 65536 : (kind == 4 ? 57344 : 0);
                bgwk.kind = kind; bgwk.cur = __builtin_amdgcn_readfirstlane((int)((long)gw * setsize / NGW)); bgwk.end = __builtin_amdgcn_readfirstlane((int)((long)(gw + 1) * setsize / NGW)); bgwk.iss = bgwk.cur; bgwk.pend0 = 0; bgwk.pend1 = 0;
                bgwk.ws = ws; bgwk.ptab = ptab;
                bgwk.scr = (LAS float*)(ldsl + 77824 + wave * 8448);
                bgwk.a0 = bgwk.a1 = bgwk.a2 = bgwk.a3 = bgwk.b0 = bgwk.b1 = bgwk.b2 = bgwk.b3 = (f32x4){0.f, 0.f, 0.f, 0.f};
            }
            if (L == 0) {
#pragma unroll 1
                for (int u = vcu; u < 512; u += G) {
                    const int grp = u >> 5, b = grp >> 2, kvh = grp & 3, h = kvh * 4 + ((u & 31) >> 3), qb = u & 7;
                    att::FWin f; const int q0 = qb * 256; int ks = q0 - 128; ks = ks < 0 ? 0 : ks; int ke = q0 + 384; ke = ke > SEQ ? SEQ : ke;
                    f.Kb = QKV + 2048 + kvh * HD; f.Vb = QKV + 2560 + kvh * HD; f.ldk = GQA_IN; f.ldv = GQA_IN; f.NT = (ke - ks) / 64; f.C = att::SC128 * att::LOG2E; f.thr_raw = att::THR * att::ISC128;
                    f.Q = QKV + (size_t)(b * SEQ + q0) * GQA_IN + h * HD; f.O = OB + (size_t)(b * SEQ + q0) * DM + h * HD; f.ldq = GQA_IN; f.ldo = DM; f.k0 = (long)b * SEQ + ks;
                    f.qpos0 = q0; f.kpos0 = ks; f.sink_raw = ldp(ptab, IN_A_SINK)[h] * att::ISC128;
                    __syncthreads();
#ifndef NO_ATTA
                    att::attn_unit<128, att::FWin, bgw::NoWork>(f, al, tid, nobg);
#endif
                }
            } else if (L == 1) {
#pragma unroll 1
                for (int u = vcu; u < 512; u += G) {
                    const int grp = u >> 5, b = grp >> 2, kvh = grp & 3, h = kvh * 4 + ((u & 31) >> 3), qb = u & 7;
                    att::FDense f; const int q0 = qb * 256;
                    f.Kb = QKV + 2048 + kvh * HD; f.Vb = QKV + 2560 + kvh * HD; f.ldk = GQA_IN; f.ldv = GQA_IN; f.NT = SEQ / 64; f.C = att::SC128 * att::LOG2E; f.thr_raw = att::THR * att::ISC128;
                    f.Q = QKV + (size_t)(b * SEQ + q0) * GQA_IN + h * HD; f.O = OB + (size_t)(b * SEQ + q0) * DM + h * HD; f.ldq = GQA_IN; f.ldo = DM; f.k0 = (long)b * SEQ;
                    __syncthreads();
#ifndef NO_ATTB
                    att::attn_unit<128, att::FDense, bgw::Work>(f, al, tid, bgwk);
#endif
                }
            } else if (L == 2) {
#pragma unroll 1
                for (int u = vcu; u < 512; u += G) {
                    const int grp = u >> 3, b = grp >> 4, h = grp & 15, qb = u & 7;
                    att::FMla f; const int q0 = qb * 256; f.tab = TABC; f.pos0 = q0;
                    f.Kb = KM + h * 192; f.Vb = VM + h * HD; f.ldk = 3072; f.ldv = 2048; f.NT = SEQ / 64; f.C = att::SC192 * att::LOG2E; f.thr_raw = att::THR / att::SC192;
                    f.Q = QKV + (size_t)(b * SEQ + q0) * 3072 + h * 192; f.O = OB + (size_t)(b * SEQ + q0) * DM + h * HD; f.ldq = 3072; f.ldo = DM; f.k0 = (long)b * SEQ;
                    __syncthreads();
#ifndef NO_ATTC
                    att::attn_unit<192, att::FMla, bgw::NoWork>(f, al, tid, nobg);
#endif
                }
            } else {
                float* bl = (float*)(al + 2 * 16384 + 2 * 64 * 272 + 2048);
#pragma unroll 1
                for (int u = vcu; u < 512; u += G) {
                    const int b = u >> 7, rq = (u & 127) >> 2, kvh = u & 3;
                    __syncthreads();
                    for (int i = tid; i < 4 * 465; i += 512) bl[i] = ldp(ptab, IN_D_RPB)[(size_t)(kvh * 4) * 465 + i] * att::ISC128;
                    att::FNat f; int rb = rq - 4; rb = rb < 0 ? 0 : (rb > 24 ? 24 : rb);
                    f.Kb = QKV + 2048 + kvh * HD; f.Vb = QKV + 2560 + kvh * HD; f.ldk = GQA_IN; f.ldv = GQA_IN; f.NT = 8; f.C = att::SC128 * att::LOG2E; f.thr_raw = att::THR * att::ISC128;
                    f.Q = QKV; f.O = OB; f.tok0 = (long)b * SEQ + rq * 64; f.kvh = kvh; f.rq = rq; f.rb = rb; f.bias = bl;
#ifndef NO_ATTD
                    att::attn_unit<128, att::FNat, bgw::NoWork>(f, al, tid, nobg);
#endif
                }
            }
            if (bgwk.kind) bg_drain(bgwk, (int)__builtin_amdgcn_mbcnt_hi(~0u, __builtin_amdgcn_mbcnt_lo(~0u, (unsigned)opq_s(0))));
        }
        SEAM(P + 5);
        if (EN(6) && IN(P + 6)) for (int rep_ = 0; rep_ < REPS(6); ++rep_) { WSP;
            const size_t wo = L == 0 ? W_A_OUT : (L == 1 ? W_B_OUT : (L == 2 ? W_C_OUT : W_D_OUT));
            pg8::PlainOrder S; S.init(OB, ws + wo, DM, DM, T, DM, G, bx);
            const size_t tr_ = (size_t)(args.flags & 1);
            pg8::EpiResidB16<true> E{HB, (bf16_t*)(ws + A_H + tr_ * (A_TRASH - A_H)), (float*)(ws + WS_SS2 + tr_ * (A_TRASH - WS_SS2)), DM};
            pg8::gemm_phase<pg8::EpiResidB16<true>, pg8::PlainOrder>(ldsl, tid, DM, DM, DM, S, E);
        }
        SEAM(P + 6);
        if (EN(8) && IN(P + 8)) for (int rep_ = 0; rep_ < REPS(8); ++rep_) { WSP;
            pg8::SplitKOrder S; S.A = (const char*)HB; S.Bt = (const char*)(ws + W_XQ + (size_t)L * 512 * 2048 * 2); S.lda = DM; S.ldb = DM; S.nN = XAI / 256; S.KS = 4; S.Kc = DM / 4; S.nwg = (T / 256) * (XAI / 256) * 4; S.G = G; S.c = vcu;
            pg8::EpiBf16Slab E{(bf16_t*)(ws + A_XG), XAI, (size_t)T * XAI};
            pg8::gemm_phase<pg8::EpiBf16Slab, pg8::SplitKOrder>(ldsl, tid, DM / 4, DM, DM, S, E);
            if (SIDE_DOWN && rep_ == 0 && bx >= (T / 256) * (XAI / 256)) {
                const int nidle = G - (T / 256) * (XAI / 256); LAS float* scr = (LAS float*)(ldsl + wave * 16384); const float* wd = ldp(ptab, IN_M_DOWN);
#pragma unroll 1
                for (int it = (bx - (T / 256) * (XAI / 256)) * 8 + wave; it < 16 * 1024; it += nidle * 8) { const int mat = L * 16 + (it >> 10), r = it & 1023, kb = r >> 6, n0 = (r & 63) * 32;
                    transpose_item(wd + (size_t)mat * 1024 * 2048, 2048, (bf16_t*)(ws + W_M2) + (size_t)mat * 2048 * 1024, 1024, 64 * kb, n0, n0, scr, lane, nullptr); }
            }
        }
        SEAM(P + 8);
        if (EN(9) && IN(P + 9)) for (int rep_ = 0; rep_ < REPS(9); ++rep_) { WSP;
            char* al = (char*)lds; const bf16_t* kv = KVX + (size_t)L * 1024 * 1024;
            const int xsp = G >= 256 ? G / 128 : 1;
#pragma unroll 1
            for (int u = (vcu % xsp == 0) ? vcu / xsp : 128; u < 128; u += G / xsp) {
                const int b = u >> 5, h = (u & 31) >> 3, qb = u & 7;
                att::FCross f; const int q0 = qb * 256; f.slab = (size_t)T * XAI; f.ss = SS2; f.row0g = b * SEQ + q0;
                f.Kb = kv + h * HD; f.Vb = kv + XAI + h * HD; f.ldk = 1024; f.ldv = 1024; f.NT = MEMT / 64; f.C = att::SC128 * att::LOG2E; f.thr_raw = att::THR * att::ISC128;
                f.Q = (const bf16_t*)(ws + A_XG) + (size_t)(b * SEQ + q0) * XAI + h * HD; f.O = OX + (size_t)(b * SEQ + q0) * XAI + h * HD; f.ldq = XAI; f.ldo = XAI; f.k0 = (long)b * MEMT;
                __syncthreads();
#ifndef NO_ATTX
                { bgw::NoWork nobg; att::attn_unit<128, att::FCross, bgw::NoWork>(f, al, tid, nobg); }
#endif
            }
            if (SIDE_X && rep_ == 0 && L != 1 && vcu >= 128) {
                const int nidle = G - 128; LAS float* scr = (LAS float*)(ldsl + wave * 16384); const float* wgp = ldp(ptab, IN_M_GATE); const float* gk = ldp(ptab, IN_GFFN) + L * DM;
#pragma unroll 1
                for (int it = (vcu - 128) * 8 + wave; it < 8 * 1024; it += nidle * 8) { const int mat = L * 16 + (it >> 10), r = it & 1023, kb = r >> 5, n0 = (r & 31) * 32;
                    transpose_item(wgp + (size_t)mat * 2048 * 1024, 1024, (bf16_t*)(ws + W_M1) + (size_t)mat * 2048 * 2048, 2048, 64 * kb, n0, (n0 >> 7) * 256 + (n0 & 127), scr, lane, gk); }
            }
        }
        SEAM(P + 9);
        if (EN(10) && IN(P + 10)) for (int rep_ = 0; rep_ < REPS(10); ++rep_) { WSP;
            pg8::PlainOrder S; S.init(OX, ws + W_XO + (size_t)L * 2048 * 512 * 2, XAI, XAI, T, DM, G, bx);
            pg8::EpiResidB16<false> E{HB, (bf16_t*)(ws + A_H + (size_t)(args.flags & 1) * (A_TRASH - A_H)), nullptr, DM};
            pg8::gemm_phase<pg8::EpiResidB16<false>, pg8::PlainOrder>(ldsl, tid, XAI, XAI, XAI, S, E);
        }
        SEAM(P + 10);
        if (EN(11) && IN(P + 11)) for (int rep_ = 0; rep_ < REPS(11); ++rep_) { WSP;
            LAS float* part = (LAS float*)ldsl;
            LAS float* ssl = part + 8 * 2 * 64 * 4;
            const u32x4* rwh = (const u32x4*)(ws + WS_RW) + (size_t)L * 8192 + (size_t)wave * 8 * 64 + lane; const u32x4* rwl = rwh + 4096;
            const int fr = lane & 15, fq = lane >> 4;
#pragma unroll 1
            for (int u = vcu; u < T / 32; u += G) {
                const bf16_t* ap = HB + (size_t)(u * 32 + fr) * DM + wave * 256 + fq * 8;
                u32x4 a0[8], a1[8], bh[8], bl[8];
#pragma unroll
                for (int s_ = 0; s_ < 8; ++s_) { a0[s_] = *(const u32x4*)(ap + s_ * 32); a1[s_] = *(const u32x4*)(ap + (size_t)16 * DM + s_ * 32); bh[s_] = rwh[s_ * 64]; bl[s_] = rwl[s_ * 64]; }
                __builtin_amdgcn_sched_barrier(0);
                f32x4 c0 = {0.f, 0.f, 0.f, 0.f}, c1 = {0.f, 0.f, 0.f, 0.f}; float ss0 = 0.f, ss1 = 0.f;
#pragma unroll
                for (int s_ = 0; s_ < 8; ++s_) {
                    c0 = __builtin_amdgcn_mfma_f32_16x16x32_bf16(__builtin_bit_cast(bf16x8, a0[s_]), __builtin_bit_cast(bf16x8, bh[s_]), c0, 0, 0, 0);
                    c1 = __builtin_amdgcn_mfma_f32_16x16x32_bf16(__builtin_bit_cast(bf16x8, a1[s_]), __builtin_bit_cast(bf16x8, bh[s_]), c1, 0, 0, 0);
                    c0 = __builtin_amdgcn_mfma_f32_16x16x32_bf16(__builtin_bit_cast(bf16x8, a0[s_]), __builtin_bit_cast(bf16x8, bl[s_]), c0, 0, 0, 0);
                    c1 = __builtin_amdgcn_mfma_f32_16x16x32_bf16(__builtin_bit_cast(bf16x8, a1[s_]), __builtin_bit_cast(bf16x8, bl[s_]), c1, 0, 0, 0);
#pragma unroll
                    for (int c = 0; c < 4; ++c) { const float x0 = __uint_as_float(a0[s_][c] << 16), x1 = __uint_as_float(a0[s_][c] & 0xffff0000u), y0 = __uint_as_float(a1[s_][c] << 16), y1 = __uint_as_float(a1[s_][c] & 0xffff0000u);
                        ss0 += x0 * x0 + x1 * x1; ss1 += y0 * y0 + y1 * y1; }
                }
                ss0 += __shfl_xor(ss0, 16); ss0 += __shfl_xor(ss0, 32); ss1 += __shfl_xor(ss1, 16); ss1 += __shfl_xor(ss1, 32);
                __syncthreads();
                *(LAS f32x4*)(part + ((wave * 2 + 0) * 64 + lane) * 4) = c0; *(LAS f32x4*)(part + ((wave * 2 + 1) * 64 + lane) * 4) = c1;
                if (fq == 0) { ssl[(wave * 2 + 0) * 16 + fr] = ss0; ssl[(wave * 2 + 1) * 16 + fr] = ss1; }
                __syncthreads();
                if (wave < 2) {
                    f32x4 lg = {0.f, 0.f, 0.f, 0.f}; f32x4 sq = {0.f, 0.f, 0.f, 0.f};
#pragma unroll
                    for (int w = 0; w < 8; ++w) { const f32x4 p = *(const LAS f32x4*)(part + ((w * 2 + wave) * 64 + lane) * 4); const f32x4 q = *(const LAS f32x4*)(ssl + (w * 2 + wave) * 16 + 4 * fq);
                        lg.x += p.x; lg.y += p.y; lg.z += p.z; lg.w += p.w; sq.x += q.x; sq.y += q.y; sq.z += q.z; sq.w += q.w; }
                    f32x4 rs, af;
#pragma unroll
                    for (int i = 0; i < 4; ++i) { rs[i] = 1.0f / sqrtf(sq[i] * (1.0f / DM) + EPS);
                        const float a1_ = lg[i] * rs[i];
                        float mx = a1_; mx = fmaxf(mx, __shfl_xor(mx, 1)); mx = fmaxf(mx, __shfl_xor(mx, 2)); mx = fmaxf(mx, __shfl_xor(mx, 4)); mx = fmaxf(mx, __shfl_xor(mx, 8));
                        const float ex = expf(a1_ - mx); float sum = ex; sum += __shfl_xor(sum, 1); sum += __shfl_xor(sum, 2); sum += __shfl_xor(sum, 4); sum += __shfl_xor(sum, 8);
                        af[i] = ex / sum; }
                    const int t = u * 32 + wave * 16 + 4 * fq;
                    *(f32x4*)(AFF + ((size_t)(t / SEQ) * NE + fr) * SEQ + (t % SEQ)) = af;
                    if (fr == 0) *(f32x4*)(RS3 + t) = rs;
                }
            }
            __syncthreads();
        }
        SEAM(P + 11);
        if (EN(12) && IN(P + 12)) for (int rep_ = 0; rep_ < REPS(12); ++rep_) { WSP;
            volatile LAS int* cnt = (volatile LAS int*)ldsl;
            const int stride = G >= 64 ? G / 64 : 1;
            if (vcu % stride == 0) {
#pragma unroll 1
                for (int u = vcu / stride; u < NB * NE; u += (G + stride - 1) / stride) {
                    const int b = u >> 4, e = u & 15; const float* ap = AFF + (size_t)u * SEQ + wave * 256;
                    unsigned kk[4];
#pragma unroll
                    for (int i = 0; i < 4; ++i) kk[i] = __float_as_uint(ap[lane + 64 * i]);
                    __syncthreads();
                    unsigned tau = 0u;
#pragma unroll 1
                    for (int sh = 28, stepi = 0; sh >= 0; sh -= 4, ++stepi) { int mine = 0;
#pragma unroll
                        for (int j = 1; j < 16; ++j) { const unsigned cand = tau | ((unsigned)j << sh); int c = 0;
#pragma unroll
                            for (int i = 0; i < 4; ++i) c += __builtin_popcountll(__ballot(kk[i] >= cand));
                            asm volatile("v_writelane_b32 %0, %1, %2" : "+v"(mine) : "s"(c), "n"(j)); }
                        const int pb = 64 + (stepi & 1) * 128; if (lane < 16) cnt[pb + wave * 16 + lane] = mine;
                        __syncthreads();
                        int tot = 0;
#pragma unroll
                        for (int w = 0; w < 8; ++w) tot += cnt[pb + w * 16 + (lane & 15)];
                        tau |= (unsigned)__builtin_popcountll(__ballot(lane >= 1 && lane < 16 && tot >= CAP)) << sh; }
                    int ngt_w = 0, neq_w = 0;
#pragma unroll
                    for (int i = 0; i < 4; ++i) { ngt_w += __builtin_popcountll(__ballot(kk[i] > tau)); neq_w += __builtin_popcountll(__ballot(kk[i] == tau)); }
                    if (lane == 0) { cnt[16 + wave] = ngt_w; cnt[24 + wave] = neq_w; }
                    __syncthreads();
                    int ngt = 0, eqbase = 0;
#pragma unroll
                    for (int w = 0; w < 8; ++w) { ngt += cnt[16 + w]; eqbase += (w < wave) ? cnt[24 + w] : 0; }
                    const int need = CAP - ngt;
                    bool sel[4]; int nsel_w = 0, eqrun = eqbase;
#pragma unroll
                    for (int i = 0; i < 4; ++i) { const bool gt = kk[i] > tau, eq = kk[i] == tau; const unsigned long long eqm = __ballot(eq);
                        const int eqr = eqrun + (int)__builtin_amdgcn_mbcnt_hi((unsigned)(eqm >> 32), __builtin_amdgcn_mbcnt_lo((unsigned)eqm, 0u));
                        sel[i] = gt || (eq && eqr < need); nsel_w += __builtin_popcountll(__ballot(sel[i])); eqrun += __builtin_popcountll(eqm); }
                    if (lane == 0) cnt[32 + wave] = nsel_w;
                    __syncthreads();
                    int selbase = 0;
#pragma unroll
                    for (int w = 0; w < 8; ++w) selbase += (w < wave) ? cnt[32 + w] : 0;
                    const int srow = u * CAP;
#pragma unroll
                    for (int i = 0; i < 4; ++i) { const unsigned long long selm = __ballot(sel[i]);
                        const int slot = selbase + (int)__builtin_amdgcn_mbcnt_hi((unsigned)(selm >> 32), __builtin_amdgcn_mbcnt_lo((unsigned)selm, 0u));
                        const int t = wave * 256 + 64 * i + lane;
                        if (sel[i]) { IDX[srow + slot] = b * SEQ + t; GATE[srow + slot] = __uint_as_float(kk[i]); RSG[srow + slot] = RS3[b * SEQ + t]; }
                        SLOT[((size_t)b * SEQ + t) * NE + e] = sel[i] ? slot : -1;
                        selbase += __builtin_popcountll(selm); }
                }
            }
            __syncthreads();
        }
        SEAM(P + 12);
        if (EN(13) && IN(P + 13)) for (int rep_ = 0; rep_ < REPS(13); ++rep_) { WSP;
            pg8::MoeGatherOrder S; S.rows = IDX; S.A = (const char*)HB; S.Bt = (const char*)(ws + W_M1 + (size_t)L * 16 * 2048 * 2048 * 2); S.lda = DM; S.ldb = DM; S.G = G; S.vcu = vcu; S.bstride = (size_t)2048 * 2048 * 2;
            pg8::EpiSwiGLU E{HMID, RSG, GATE};
            pg8::gemm_phase<pg8::EpiSwiGLU, pg8::MoeGatherOrder>(ldsl, tid, DM, DM, DM, S, E);
        }
        SEAM(P + 13);
        if (EN(14) && IN(P + 14)) for (int rep_ = 0; rep_ < REPS(14); ++rep_) { WSP;
            pg8::MoeOrder S; S.A = (const char*)HMID; S.Bt = (const char*)(ws + W_M2 + (size_t)L * 16 * 2048 * 1024 * 2); S.lda = FF; S.ldb = FF; S.G = G; S.vcu = vcu; S.bstride = (size_t)2048 * 1024 * 2;
            pg8::EpiBf16 E{YB, DM};
            pg8::gemm_phase<pg8::EpiBf16, pg8::MoeOrder>(ldsl, tid, FF, FF, FF, S, E);
        }
        SEAM(P + 14);
    }
    if (XTRA_BAR && IN(PH_FINAL) && lo < PH_FINAL) { for (int i_ = 0; i_ < XTRA_BAR; ++i_) xcd_barrier(bar, TID0); }
    if (EN(16) && IN(PH_FINAL)) for (int rep_ = 0, L_ = 0; rep_ < REPS(16); ++rep_) { WSP;
        for (int t = gw; t < T; t += NGW) {
            f32x4 v[8]; rowb_load(HB + (size_t)t * DM, lane, v);
            row_combine(v, SLOT + (size_t)t * NE, YB, t / SEQ, lane);
            const float rstd = row_rstd(v); const float* g = ldp(ptab, IN_FINALG);
#pragma unroll
            for (int j = 0; j < 8; ++j) { const f32x4 gg = *(const f32x4*)(g + 4 * lane + 256 * j);
                *(f32x4*)(args.out + (size_t)t * DM + 4 * lane + 256 * j) = (f32x4){v[j].x * rstd * gg.x, v[j].y * rstd * gg.y, v[j].z * rstd * gg.z, v[j].w * rstd * gg.w}; }
        }
    }
#undef IN
#undef SEAM
#undef H
}

#ifndef EXP_PHASE
#define EXP_PHASE -1
#endif
#ifndef EXP_REPS
#define EXP_REPS 8
#endif
static bool phase_nonempty(int p) {
    if (p == 0 || p == PH_FINAL) return true;
    const int L = (p - 1) / PH_PER_LAYER, k = (p - 1) % PH_PER_LAYER;
    if (k == 0) return L > 0;
    if (k == 2) return L != 3;
    if (k == 3) return L == 2;
    if (k == 4) return false;
    if (k == 7) return false;
    return true;
}
extern "C" void kernel_launch(void* const* d_in, const int* in_sizes, int n_in, void* d_out, int out_size, void* d_ws, size_t ws_size, hipStream_t stream) {
    static int grid = 0;
    if (grid == 0) {
        if (n_in != 30 || out_size != T * DM || ws_size < WS_END) { fprintf(stderr, "kernel_launch: unexpected shapes (n_in %d, out %d, ws %zu < %zu); nothing launched\n", n_in, out_size, ws_size, (size_t)WS_END); grid = -1; return; }
        int dev = 0, cus = 0, per_cu = 0;
        if (hipGetDevice(&dev) != hipSuccess || hipDeviceGetAttribute(&cus, hipDeviceAttributeMultiprocessorCount, dev) != hipSuccess) { grid = -1; return; }
        if (hipFuncSetAttribute((const void*)fwd, hipFuncAttributeMaxDynamicSharedMemorySize, LDS_BYTES) != hipSuccess) { fprintf(stderr, "kernel_launch: hipFuncSetAttribute failed\n"); grid = -1; return; }
        if (hipOccupancyMaxActiveBlocksPerMultiprocessor(&per_cu, (const void*)fwd, 512, LDS_BYTES) != hipSuccess || per_cu < 1) { fprintf(stderr, "kernel_launch: occupancy query says %d\n", per_cu); }
        (void)hipGetLastError();
        grid = cus;
    }
    if (grid < 0) return;
    (void)hipMemsetAsync((char*)d_ws + WS_CTL, 0, CTL_BYTES, stream);
    Args a{};
    for (int i = 0; i < 30; ++i) a.in[i] = (const float*)d_in[i];
    a.out = (float*)d_out; a.ws = (unsigned char*)d_ws;
#if MK_SINGLE
    a.ph_lo = 0; a.ph_hi = N_PHASES;
    hipLaunchKernelGGL(fwd, dim3(grid), dim3(512), LDS_BYTES, stream, a);
#else
    for (int p = 0; p < N_PHASES; ++p) {
        if (!phase_nonempty(p)) continue;
        a.ph_lo = p; a.ph_hi = p + 1; a.flags = 0;
        hipLaunchKernelGGL(fwd, dim3(grid), dim3(512), LDS_BYTES, stream, a);
        if (p == EXP_PHASE) { const int k = (p - 1) % PH_PER_LAYER; a.flags = (p > 0 && p < PH_FINAL && (k == 0 || k == 6 || k == 10)) ? 1 : 0;
            for (int r = 0; r < EXP_REPS; ++r) hipLaunchKernelGGL(fwd, dim3(grid), dim3(512), LDS_BYTES, stream, a); }
    }
#endif
    const hipError_t le = hipPeekAtLastError();
    if (le != hipSuccess) fprintf(stderr, "kernel_launch: launch failed: %s\n", hipGetErrorName(le));
}
```
